# Optimizing an MI355X kernel written in HIP

```python
import math
import jax, jax.numpy as jnp
from jax import lax
import numpy as np

D_MODEL = 1024
BATCH = 4
SEQ = 4096
DEPTH = 1

MEM_LEN = 256
HEAD_DIM = 64
GMLP_HEADS = 4
ATTN_HEADS = 8
MEM_HEADS = 4
GMLP_WIDTH = GMLP_HEADS * HEAD_DIM
ATTN_WIDTH = ATTN_HEADS * HEAD_DIM
MEM_WIDTH = MEM_HEADS * HEAD_DIM
MIX_WIDTH = GMLP_WIDTH + ATTN_WIDTH + MEM_WIDTH
IN_WIDTH = 3 * GMLP_WIDTH + 4 * ATTN_WIDTH + 2 * MEM_WIDTH
CHUNK = 128
BLOCK = 128
DILATED_CONFIGS = ((128, 1), (512, 4), (2048, 16))
PAD_MULT = max(d for _, d in DILATED_CONFIGS) * BLOCK
EPS = 1e-6

kernel_name = "hybrid_gmlp_dilated_memory_layer"


def _rms(x, g):
    xf = x.astype(jnp.float32)
    y = xf * lax.rsqrt(jnp.mean(xf * xf, axis=-1, keepdims=True) + EPS)
    return (y * g.astype(jnp.float32)).astype(x.dtype)


def _dilated_branch(q, k, v, dilation, n_win):
    B, Sp, H, hd = q.shape
    L = Sp // dilation
    nb = L // BLOCK

    def to_blocks(t):
        return t.reshape(B, L, dilation, H, hd).transpose(0, 2, 3, 1, 4).reshape(B, dilation, H, nb, BLOCK, hd)

    def with_prev(t):
        prev = jnp.pad(t, ((0, 0), (0, 0), (0, 0), (1, 0), (0, 0), (0, 0)))[:, :, :, :-1]
        return jnp.concatenate([prev, t], axis=4)

    qb = to_blocks(q)
    kc = with_prev(to_blocks(k))
    vc = with_prev(to_blocks(v))
    s = jnp.einsum('bdhnqc,bdhnkc->bdhnqk', qb, kc).astype(jnp.float32) * (1.0 / math.sqrt(hd))
    qi = jnp.arange(BLOCK)[:, None] + BLOCK
    ki = jnp.arange(2 * BLOCK)[None, :]
    rel = qi - ki
    blk = jnp.arange(nb)[:, None, None]
    valid = (rel >= 0) & (rel <= n_win) & ((blk > 0) | (ki >= BLOCK))
    s = jnp.where(valid, s, -jnp.inf)
    lse = jax.nn.logsumexp(s, axis=-1)
    p = jnp.exp(s - lse[..., None])
    o = jnp.einsum('bdhnqk,bdhnkc->bdhnqc', p.astype(v.dtype), vc)
    o = o.reshape(B, dilation, H, L, hd).transpose(0, 3, 1, 2, 4).reshape(B, Sp, H, hd)
    lse = lse.reshape(B, dilation, H, L).transpose(0, 3, 1, 2).reshape(B, Sp, H)
    return o, lse


def _dilated_attention(q, k, v):
    B, S, H, hd = q.shape
    Sp = ((S + PAD_MULT - 1) // PAD_MULT) * PAD_MULT
    pad = ((0, 0), (0, Sp - S), (0, 0), (0, 0))
    qp, kp, vp = jnp.pad(q, pad), jnp.pad(k, pad), jnp.pad(v, pad)
    outs, lses = [], []
    for window, dil in DILATED_CONFIGS:
        o, l = _dilated_branch(qp, kp, vp, dil, window // dil)
        outs.append(o)
        lses.append(l)
    w = jax.nn.softmax(jnp.stack(lses, axis=0), axis=0)
    out = sum(w[i][..., None] * outs[i].astype(jnp.float32) for i in range(len(outs)))
    return out[:, :S].astype(q.dtype)


def _chunked_gmlp(u, v, v_gain, w_s, b_s):
    B, S, GH, hd = v.shape
    nc = S // CHUNK
    vn = _rms(v, v_gain).reshape(B, nc, CHUNK, GH, hd)
    tril = jnp.tril(jnp.ones((CHUNK, CHUNK), dtype=w_s.dtype))
    sp = jnp.einsum('hts,bcshd->bcthd', w_s * tril, vn) + b_s.T[:, :, None]
    return u * sp.reshape(B, S, GH, hd)


def _memory_attention(qm, mem, mem_gain, w_mem_kv, q_gain, k_gain):
    B, S, H, hd = qm.shape
    kv = _rms(mem, mem_gain) @ w_mem_kv
    mk, mv = jnp.split(kv, 2, axis=-1)
    mk = _rms(mk.reshape(B, -1, H, hd), k_gain)
    mv = mv.reshape(B, -1, H, hd)
    qn = _rms(qm, q_gain)
    s = jnp.einsum('bshc,bmhc->bhsm', qn, mk).astype(jnp.float32) * (1.0 / math.sqrt(hd))
    p = jax.nn.softmax(s, axis=-1)
    return jnp.einsum('bhsm,bmhc->bshc', p.astype(mv.dtype), mv)


def setup_inputs(seed: int = 0) -> dict:
    key = jax.random.key(seed)
    ks = jax.random.split(key, 16)
    f32 = jnp.float32
    x = jax.random.normal(ks[0], (BATCH, SEQ, D_MODEL), f32)
    mem = jax.random.normal(ks[1], (BATCH, MEM_LEN, D_MODEL), f32)
    norm_gain = 1.0 + 0.02 * jax.random.normal(ks[2], (DEPTH, D_MODEL), f32)
    w_in = jax.random.normal(ks[3], (DEPTH, D_MODEL, IN_WIDTH), f32) * D_MODEL ** -0.5
    gmlp_v_gain = 1.0 + 0.02 * jax.random.normal(ks[4], (DEPTH, GMLP_HEADS, HEAD_DIM), f32)
    gmlp_w_s = jax.random.normal(ks[5], (DEPTH, GMLP_HEADS, CHUNK, CHUNK), f32) * CHUNK ** -0.5
    gmlp_b = 1.0 + 0.02 * jax.random.normal(ks[6], (DEPTH, GMLP_HEADS, CHUNK), f32)
    attn_q_gain = 1.0 + 0.02 * jax.random.normal(ks[7], (DEPTH, HEAD_DIM), f32)
    attn_k_gain = 1.0 + 0.02 * jax.random.normal(ks[8], (DEPTH, HEAD_DIM), f32)
    mem_norm_gain = 1.0 + 0.02 * jax.random.normal(ks[9], (DEPTH, D_MODEL), f32)
    w_mem_kv = jax.random.normal(ks[10], (DEPTH, D_MODEL, 2 * MEM_WIDTH), f32) * D_MODEL ** -0.5
    mem_q_gain = 1.0 + 0.02 * jax.random.normal(ks[11], (DEPTH, HEAD_DIM), f32)
    mem_k_gain = 1.0 + 0.02 * jax.random.normal(ks[12], (DEPTH, HEAD_DIM), f32)
    w_out = jax.random.normal(ks[13], (DEPTH, MIX_WIDTH, D_MODEL), f32) * MIX_WIDTH ** -0.5
    return {"x": x, "mem": mem, "norm_gain": norm_gain, "w_in": w_in,
            "gmlp_v_gain": gmlp_v_gain, "gmlp_w_s": gmlp_w_s, "gmlp_b": gmlp_b,
            "attn_q_gain": attn_q_gain, "attn_k_gain": attn_k_gain,
            "mem_norm_gain": mem_norm_gain, "w_mem_kv": w_mem_kv,
            "mem_q_gain": mem_q_gain, "mem_k_gain": mem_k_gain, "w_out": w_out}


def reference(x, mem, norm_gain, w_in, gmlp_v_gain, gmlp_w_s, gmlp_b,
              attn_q_gain, attn_k_gain, mem_norm_gain, w_mem_kv,
              mem_q_gain, mem_k_gain, w_out):
    B, S, _ = x.shape
    split_points = np.cumsum([GMLP_WIDTH] * 3 + [ATTN_WIDTH] * 4 + [MEM_WIDTH])
    for l in range(DEPTH):
        h = _rms(x, norm_gain[l])
        proj = h @ w_in[l]
        g_u, g_v, g_gate, a_q, a_k, a_v, a_gate, m_q, m_gate = jnp.split(proj, split_points, axis=-1)

        y_g = _chunked_gmlp(g_u.reshape(B, S, GMLP_HEADS, HEAD_DIM), g_v.reshape(B, S, GMLP_HEADS, HEAD_DIM),
                            gmlp_v_gain[l], gmlp_w_s[l], gmlp_b[l]).reshape(B, S, GMLP_WIDTH)
        y_g = y_g * jax.nn.silu(g_gate)

        q = _rms(a_q.reshape(B, S, ATTN_HEADS, HEAD_DIM), attn_q_gain[l])
        k = _rms(a_k.reshape(B, S, ATTN_HEADS, HEAD_DIM), attn_k_gain[l])
        v = a_v.reshape(B, S, ATTN_HEADS, HEAD_DIM)
        y_a = _dilated_attention(q, k, v).reshape(B, S, ATTN_WIDTH) * jax.nn.silu(a_gate)

        y_m = _memory_attention(m_q.reshape(B, S, MEM_HEADS, HEAD_DIM), mem, mem_norm_gain[l], w_mem_kv[l],
                                mem_q_gain[l], mem_k_gain[l]).reshape(B, S, MEM_WIDTH)
        y_m = y_m * jax.nn.silu(m_gate)

        y = jnp.concatenate([y_g, y_a, y_m], axis=-1) @ w_out[l]
        x = x + y
    return x
```

```cpp
#include <hip/hip_runtime.h>
#include <hip/hip_cooperative_groups.h>
#include <cstdio>
namespace cg = cooperative_groups;

typedef unsigned short bf16_t;
typedef short bf16x8 __attribute__((ext_vector_type(8)));
typedef short s16x4 __attribute__((ext_vector_type(4)));
typedef float f32x4 __attribute__((ext_vector_type(4)));
typedef unsigned u32x4 __attribute__((ext_vector_type(4)));
typedef unsigned u32x2 __attribute__((ext_vector_type(2)));
#define DI __device__ __forceinline__
#define LDS3 __attribute__((address_space(3)))

constexpr int NTHREADS = 512;
constexpr int D_MODEL = 1024, SEQ = 4096, BATCH = 4, NTOK = BATCH * SEQ, MEM_LEN = 256, NMEM = BATCH * MEM_LEN;
constexpr int IN_W = 3328;
constexpr int C_GU = 0, C_GV = 256, C_GG = 512, C_AQ = 768, C_AK = 1280, C_AV = 1792, C_AG = 2304, C_MQ = 2816, C_MG = 3072;
constexpr int SMEM_BYTES = 131072;
constexpr float LOG2E = 1.4426950408889634f;
constexpr float QSCALE = 0.125f * LOG2E;

struct Params {
  const float *x, *mem, *norm_gain, *w_in, *gv_gain, *w_s, *gmlp_b, *aq_gain, *ak_gain, *mem_norm_gain, *w_mem_kv, *mq_gain, *mk_gain, *w_out;
  float* out;
  bf16_t *wt_in, *wt_out, *wt_mem, *wsb, *xb, *memb, *proj, *memkv, *opart, *mix, *ug;
  float *lpart, *bounds;
  unsigned* bar;
};

typedef __bf16 bf16v2 __attribute__((ext_vector_type(2)));
typedef float f32x2 __attribute__((ext_vector_type(2)));
DI unsigned pk_bf16(float lo, float hi) { const f32x2 f = {lo, hi}; return __builtin_bit_cast(unsigned, __builtin_convertvector(f, bf16v2)); }
DI float bf_lo(unsigned u) { return __uint_as_float(u << 16); }
DI float bf_hi(unsigned u) { return __uint_as_float(u & 0xffff0000u); }
DI float silu_f(float v) { return v * __builtin_amdgcn_rcpf(1.0f + __builtin_amdgcn_exp2f(-LOG2E * v)); }
DI int tid_opaque() { int t = threadIdx.x; asm volatile("" : "+v"(t)); return t; }
DI f32x4 mfma16(bf16x8 a, bf16x8 b, f32x4 c) { return __builtin_amdgcn_mfma_f32_16x16x32_bf16(a, b, c, 0, 0, 0); }

#define XB_TMO      128
#define XB_XCNT(j)  (256  + 64 * (j))
#define XB_XSUB(j)  (1280 + 64 * (j))
#define XB_XGEN(j)  (2304 + 64 * (j))
#define XB_TOP      3328
#define XB_TOPGEN   3392
#define XCD_BAR_WORDS 3456
#define XB_SPIN_CAP (1u << 22)
DI unsigned xb_ld(unsigned* p) { return __hip_atomic_load(p, __ATOMIC_RELAXED, __HIP_MEMORY_SCOPE_AGENT); }
DI unsigned xb_add(unsigned* p, unsigned v) { return __hip_atomic_fetch_add(p, v, __ATOMIC_RELAXED, __HIP_MEMORY_SCOPE_AGENT); }
DI unsigned xb_xcc_id() { return (unsigned)__builtin_amdgcn_s_getreg((3 << 11) | 20) & 0xFu; }
#define XB_SPIN(cond, bar) do { unsigned _sp = 0; while (cond) { __builtin_amdgcn_s_sleep(1); \
    if ((++_sp & 255u) == 0u) { if (xb_ld(&(bar)[XB_TMO])) break; if (_sp > XB_SPIN_CAP) { atomicAdd(&(bar)[XB_TMO], 1u); break; } } } } while (0)
struct XcdBarrier { unsigned* bar; unsigned x; volatile LDS3 unsigned* st; };
DI XcdBarrier xcd_barrier_post(unsigned* bar, volatile LDS3 unsigned* st) {
  XcdBarrier b; b.bar = bar; b.x = xb_xcc_id(); b.st = st;
  if (threadIdx.x == 0) (void)xb_add(&bar[XB_XCNT(b.x)], 1u);
  return b;
}
DI void xcd_barrier_complete(unsigned* bar, unsigned x, unsigned& nloc, unsigned& nx) {
  const unsigned G = gridDim.x * gridDim.y * gridDim.z;
  unsigned sum, cnt, mine, sp = 0u;
  for (;;) {
    sum = 0u; cnt = 0u; mine = 0u;
#pragma unroll
    for (unsigned j = 0; j < 16; ++j) { const unsigned c = xb_ld(&bar[XB_XCNT(j)]); sum += c; cnt += (c > 0u) ? 1u : 0u; mine = (j == x) ? c : mine; }
    if (sum == G) break;
    __builtin_amdgcn_s_sleep(1);
    if ((++sp & 255u) == 0u) { if (xb_ld(&bar[XB_TMO])) break; if (sp > XB_SPIN_CAP) { atomicAdd(&bar[XB_TMO], 1u); break; } }
  }
  nloc = mine > 0u ? mine : 1u; nx = cnt > 0u ? cnt : 1u;
}
DI void xcd_barrier(const XcdBarrier& b) {
  asm volatile("s_waitcnt vmcnt(0)" ::: "memory");
  __syncthreads();
  if (threadIdx.x == 0) {
    unsigned* bar = b.bar;
    __builtin_amdgcn_s_waitcnt(0);
    unsigned nloc = b.st[0], nx = b.st[1];
    if (nloc == 0u) { xcd_barrier_complete(bar, b.x, nloc, nx); b.st[0] = nloc; b.st[1] = nx; }
    const unsigned old = xb_add(&bar[XB_XSUB(b.x)], 1u);
    const unsigned gen = old / nloc;
    if (old + 1u == (gen + 1u) * nloc) {
      __builtin_amdgcn_fence(__ATOMIC_RELEASE, "agent");
      asm volatile("s_waitcnt vmcnt(0)" ::: "memory");
      const unsigned og = xb_add(&bar[XB_TOP], 1u);
      const unsigned tg = og / nx;
      if (og + 1u == (tg + 1u) * nx) xb_add(&bar[XB_TOPGEN], 1u);
      else XB_SPIN(xb_ld(&bar[XB_TOPGEN]) == tg, bar);
      __builtin_amdgcn_fence(__ATOMIC_ACQUIRE, "agent");
      xb_add(&bar[XB_XGEN(b.x)], 1u);
      asm volatile("s_waitcnt vmcnt(0)" ::: "memory");
    } else {
      XB_SPIN(xb_ld(&bar[XB_XGEN(b.x)]) == gen, bar);
      __builtin_amdgcn_fence(__ATOMIC_ACQUIRE, "agent");
      asm volatile("s_waitcnt vmcnt(0)" ::: "memory");
    }
  }
  __syncthreads();
}

DI void phase_prep(const Params& p, char* smem) {
  const int tid = threadIdx.x, lane = tid & 63, wid = tid >> 6;
  constexpr int T_IN = 16 * 52, T_OUT = 16 * 16, T_MEM = 16 * 8, NT = T_IN + T_OUT + T_MEM;
  constexpr int NR = (NTOK + NMEM) / 8, NW = 32;
  constexpr int TOTAL = NT + NR + NW + 1;
  {
    auto tile_desc = [&](int t, const float*& src, const float*& gain, bf16_t*& dst, int& N, int& tk, int& tn) {
      const bool a = t < T_IN, b = t < T_IN + T_OUT;
      src = a ? p.w_in : (b ? p.w_out : p.w_mem_kv);
      gain = a ? p.norm_gain : (b ? nullptr : p.mem_norm_gain);
      dst = a ? p.wt_in : (b ? p.wt_out : p.wt_mem);
      N = a ? IN_W : (b ? 1024 : 512);
      t -= a ? 0 : (b ? T_IN : T_IN + T_OUT);
      const int ntn = N >> 6; tk = t / ntn; tn = t % ntn;
    };
    float rv[8], rg[8];
    auto tile_load = [&](int t) {
      const float* src; const float* gain; bf16_t* dst; int N, tk, tn; tile_desc(t, src, gain, dst, N, tk, tn);
#pragma unroll
      for (int i = 0; i < 8; ++i) {
        const int idx = tid + NTHREADS * i, r = idx >> 6, c = idx & 63, k = tk * 64 + r;
        rv[i] = src[(size_t)k * N + tn * 64 + c];
        rg[i] = gain ? gain[k] : 1.0f;
      }
    };
    int it = blockIdx.x;
    if (it < NT) tile_load(it);
    float* tile = (float*)smem;
    for (; it < NT; it += gridDim.x) {
      const float* src; const float* gain; bf16_t* dst; int N, tk, tn; tile_desc(it, src, gain, dst, N, tk, tn);
#pragma unroll
      for (int i = 0; i < 8; ++i) { const int idx = tid + NTHREADS * i, r = idx >> 6, c = idx & 63; tile[r * 65 + c] = rv[i] * rg[i]; }
      __syncthreads();
      if (it + (int)gridDim.x < NT) tile_load(it + gridDim.x);
#pragma unroll
      for (int i = 0; i < 4; ++i) {
        const int idx = tid + NTHREADS * i, c = idx >> 5, r2 = (idx & 31) * 2;
        const int tnd = (src == p.w_in) ? ((tn == 2 || tn == 3) ? tn + 6 : ((tn == 8 || tn == 9) ? tn - 6 : tn)) : tn;
        *(unsigned*)(dst + (size_t)(tnd * 64 + c) * 1024 + tk * 64 + r2) = pk_bf16(tile[r2 * 65 + c], tile[(r2 + 1) * 65 + c]);
      }
      __syncthreads();
    }
  }
  for (int it = NT + blockIdx.x; it < TOTAL; it += gridDim.x) {
    if (false) {
    } else if (it < NT + NR) {
      const int row = (it - NT) * 8 + wid;
      const float* src; bf16_t* dst;
      if (row < NTOK) { src = p.x + (size_t)row * 1024; dst = p.xb + (size_t)row * 1024; }
      else { const int r2 = row - NTOK; src = p.mem + (size_t)r2 * 1024; dst = p.memb + (size_t)r2 * 1024; }
      f32x4 v[4]; float ss = 0.f;
#pragma unroll
      for (int i = 0; i < 4; ++i) { v[i] = ((const f32x4*)src)[i * 64 + lane]; ss += v[i][0] * v[i][0] + v[i][1] * v[i][1] + v[i][2] * v[i][2] + v[i][3] * v[i][3]; }
#pragma unroll
      for (int o = 32; o >= 1; o >>= 1) ss += __shfl_xor(ss, o);
      const float rn = rsqrtf(ss * (1.0f / 1024.0f) + 1e-6f);
#pragma unroll
      for (int i = 0; i < 4; ++i) { u32x2 pk; pk[0] = pk_bf16(v[i][0] * rn, v[i][1] * rn); pk[1] = pk_bf16(v[i][2] * rn, v[i][3] * rn); ((u32x2*)dst)[i * 64 + lane] = pk; }
    } else if (it < NT + NR + NW) {
      const int base = (it - NT - NR) * 2048 + tid * 4;
      const f32x4 v = *(const f32x4*)(p.w_s + base);
      const int t = (base >> 7) & 127, s = base & 127;
      u32x2 pk;
      pk[0] = pk_bf16(s <= t ? v[0] : 0.f, s + 1 <= t ? v[1] : 0.f);
      pk[1] = pk_bf16(s + 2 <= t ? v[2] : 0.f, s + 3 <= t ? v[3] : 0.f);
      *(u32x2*)(p.wsb + base) = pk;
    } else {
      if (wid == 0) {
        float a = fabsf(p.aq_gain[lane]), b = fabsf(p.ak_gain[lane]), c = fabsf(p.mq_gain[lane]), d = fabsf(p.mk_gain[lane]);
#pragma unroll
        for (int o = 32; o >= 1; o >>= 1) { a = fmaxf(a, __shfl_xor(a, o)); b = fmaxf(b, __shfl_xor(b, o)); c = fmaxf(c, __shfl_xor(c, o)); d = fmaxf(d, __shfl_xor(d, o)); }
        if (lane == 0) { p.bounds[0] = 8.0f * a * b * LOG2E; p.bounds[1] = 8.0f * c * d * LOG2E; }
      }
    }
  }
}

constexpr int BM = 256, BK = 64, HALF = 128, HT = HALF * BK;
DI int lds_byte(int r, int c) { const int st = (r >> 4) * 2 + (c >> 5), rr = r & 15, cc = c & 31, ob = rr * 64 + cc * 2; return st * 1024 + (ob ^ (((ob >> 9) & 1) << 5)); }
DI void stage_rc(int b, int& R, int& C) { const int st = b / 1024, sb = b % 1024, swz = sb ^ (((sb >> 9) & 1) << 5); R = (st >> 1) * 16 + swz / 64; C = (st & 1) * 32 + (swz % 64) / 2; }
DI int perm32(int rho) { const int n = rho >> 4, i = rho & 15; return 8 * (i >> 2) + 4 * n + (i & 3); }

template <int K, class Epi>
DI void gemm256(const bf16_t* __restrict__ A, const bf16_t* __restrict__ Bt, const int brow, const int bcol, char* smem, const Epi& epi) {
  LDS3 unsigned char* lds = (LDS3 unsigned char*)smem;
  const int tid = threadIdx.x, wid = __builtin_amdgcn_readfirstlane(tid >> 6), lane = tid & 63, wr = wid >> 2, wc = wid & 3, fr = lane & 15, fq = lane >> 4;
  constexpr int HTB = HT * 2;
  unsigned voffA[2], voffB[2];
#pragma unroll
  for (int i = 0; i < 2; ++i) { int R, C; stage_rc(tid * 16 + i * 8192, R, C); voffA[i] = (unsigned)(R * K + C) * 2u; voffB[i] = (unsigned)(((R & ~31) + perm32(R & 31)) * K + C) * 2u; }
  constexpr size_t kstep = (size_t)BK * 2, hstep = (size_t)HALF * K * 2;
  const unsigned ldsw = (unsigned)wid * 1024u;
  const int aoff = lds_byte(wr * 64 + fr, fq * 8), boff = lds_byte(wc * 32 + fr, fq * 8);
  const char* cA = (const char*)A + (size_t)brow * K * 2;
  const char* cB = (const char*)Bt + (size_t)bcol * K * 2;
#define SA(b, h) (((b) * 2 + (h)) * HTB)
#define SB(b, h) ((4 + (b) * 2 + (h)) * HTB)
#define STAGE(bufoff, gbase, voff) do { _Pragma("unroll") for (int _i = 0; _i < 2; ++_i) \
    __builtin_amdgcn_global_load_lds((const unsigned*)((const char*)(gbase) + (voff)[_i]), (LDS3 unsigned*)(lds + (bufoff) + ldsw + _i * 8192), 16, 0, 0); } while (0)
#define LDA(dst, b, h) do { _Pragma("unroll") for (int m = 0; m < 4; ++m) _Pragma("unroll") for (int k = 0; k < 2; ++k) dst[m][k] = *(const LDS3 bf16x8*)(lds + SA(b, h) + aoff + m * 2048 + k * 1024); } while (0)
#define LDB(dst, b, h) do { _Pragma("unroll") for (int n = 0; n < 2; ++n) _Pragma("unroll") for (int k = 0; k < 2; ++k) dst[n][k] = *(const LDS3 bf16x8*)(lds + SB(b, h) + boff + n * 2048 + k * 1024); } while (0)
#define MMA(ai, bj, At_, Bt_) do { __builtin_amdgcn_s_setprio(1); \
    _Pragma("unroll") for (int m = 0; m < 4; ++m) _Pragma("unroll") for (int n = 0; n < 2; ++n) _Pragma("unroll") for (int k = 0; k < 2; ++k) \
      acc[ai][bj][m][n] = __builtin_amdgcn_mfma_f32_16x16x32_bf16(Bt_[n][k], At_[m][k], acc[ai][bj][m][n], 0, 0, 0); \
    __builtin_amdgcn_s_setprio(0); } while (0)
#define WAIT_V(n) asm volatile("s_waitcnt vmcnt(" #n ")" ::: "memory")
#define WAIT_L(n) asm volatile("s_waitcnt lgkmcnt(" #n ")" ::: "memory")
#define BAR __builtin_amdgcn_s_barrier()
#define SCHED __builtin_amdgcn_sched_barrier(0)
  f32x4 acc[2][2][4][2];
  bf16x8 At[4][2], B0[2][2], B1[2][2];
  constexpr int nt = K / BK;
  WAIT_V(0);
  STAGE(SB(0, 0), cB, voffB); STAGE(SA(0, 0), cA, voffA); STAGE(SB(0, 1), cB + hstep, voffB); STAGE(SA(0, 1), cA + hstep, voffA);
  if (wr == 1) BAR;
  WAIT_V(4); BAR;
  STAGE(SB(1, 0), cB + kstep, voffB); STAGE(SA(1, 0), cA + kstep, voffA); STAGE(SB(1, 1), cB + hstep + kstep, voffB);
  WAIT_V(6); BAR;
  epi.init(acc, brow + wr * 64 + fr, bcol + wc * 32 + 8 * fq);
  for (int t = 0; t < nt - 2; t += 2) {
    const char* a1 = cA + (size_t)(t + 1) * kstep;
    const char* a2 = cA + (size_t)(t + 2) * kstep; const char* b2 = cB + (size_t)(t + 2) * kstep;
    const char* a3 = a2 + kstep; const char* b3 = b2 + kstep;
    LDB(B0, 0, 0); SCHED; LDA(At, 0, 0); STAGE(SA(1, 1), a1 + hstep, voffA);
    WAIT_L(8); BAR; WAIT_L(0); MMA(0, 0, At, B0); BAR; SCHED;
    LDB(B1, 0, 1); STAGE(SB(0, 0), b2, voffB);
    BAR; WAIT_L(0); MMA(0, 1, At, B1); BAR;
    LDA(At, 0, 1); STAGE(SA(0, 0), a2, voffA);
    BAR; WAIT_L(0); MMA(1, 0, At, B0); BAR; SCHED;
    STAGE(SB(0, 1), b2 + hstep, voffB);
    WAIT_V(6); BAR; MMA(1, 1, At, B1); BAR;
    LDB(B0, 1, 0); SCHED; LDA(At, 1, 0); STAGE(SA(0, 1), a2 + hstep, voffA);
    WAIT_L(8); BAR; WAIT_L(0); MMA(0, 0, At, B0); BAR; SCHED;
    LDB(B1, 1, 1); STAGE(SB(1, 0), b3, voffB);
    BAR; WAIT_L(0); MMA(0, 1, At, B1); BAR;
    LDA(At, 1, 1); STAGE(SA(1, 0), a3, voffA);
    BAR; WAIT_L(0); MMA(1, 0, At, B0); BAR; SCHED;
    STAGE(SB(1, 1), b3 + hstep, voffB);
    WAIT_V(6); BAR; MMA(1, 1, At, B1); BAR;
  }
  { LDB(B0, 0, 0); LDA(At, 0, 0); STAGE(SA(1, 1), cA + (size_t)(nt - 1) * kstep + hstep, voffA);
    BAR; WAIT_L(0); MMA(0, 0, At, B0); BAR;
    LDB(B1, 0, 1); BAR; WAIT_L(0); MMA(0, 1, At, B1); BAR;
    LDA(At, 0, 1); WAIT_V(4); BAR; WAIT_L(0); MMA(1, 0, At, B0); MMA(1, 1, At, B1); BAR; }
  { LDB(B0, 1, 0); LDA(At, 1, 0); WAIT_V(2); BAR; WAIT_L(0); MMA(0, 0, At, B0); BAR;
    LDB(B1, 1, 1); WAIT_V(0); BAR; WAIT_L(0); MMA(0, 1, At, B1); BAR;
    LDA(At, 1, 1); BAR; WAIT_L(0); MMA(1, 0, At, B0); MMA(1, 1, At, B1); BAR; }
  if (wr == 0) BAR;
  epi(acc, brow + wr * 64 + fr, bcol + wc * 32 + 8 * fq);
#undef SA
#undef SB
#undef STAGE
#undef LDA
#undef LDB
#undef MMA
}

struct EpiProj {
  bf16_t* O; int ldo; int mode; const float* gain; int ghs; float scale; char* smem; bf16_t* ug; int ugc;
  DI void init(f32x4 (&acc)[2][2][4][2], int, int) const {
#pragma unroll
    for (int a = 0; a < 2; ++a)
#pragma unroll
      for (int b = 0; b < 2; ++b)
#pragma unroll
        for (int m = 0; m < 4; ++m) { acc[a][b][m][0] = (f32x4){0.f, 0.f, 0.f, 0.f}; acc[a][b][m][1] = (f32x4){0.f, 0.f, 0.f, 0.f}; }
  }
  DI void operator()(f32x4 (&acc)[2][2][4][2], int row0, int col0) const {
    const int tid = threadIdx.x, wid = tid >> 6, lane = tid & 63, fr = lane & 15, fq = lane >> 4, wc = wid & 3;
    float f[2][2][4];
    f32x4 g[2][2];
#pragma unroll
    for (int ai = 0; ai < 2; ++ai)
#pragma unroll
      for (int m = 0; m < 4; ++m) { f[0][ai][m] = 1.0f; f[1][ai][m] = 1.0f; }
#pragma unroll
    for (int bj = 0; bj < 2; ++bj) { g[bj][0] = (f32x4){1.f, 1.f, 1.f, 1.f}; g[bj][1] = (f32x4){1.f, 1.f, 1.f, 1.f}; }
    if (mode == 2) {
      LDS3 float* red = (LDS3 float*)smem;
      float part[2][2][4];
#pragma unroll
      for (int bj = 0; bj < 2; ++bj)
#pragma unroll
        for (int ai = 0; ai < 2; ++ai)
#pragma unroll
          for (int m = 0; m < 4; ++m) {
            const f32x4 a = acc[ai][bj][m][0], b = acc[ai][bj][m][1];
            float ss = a[0] * a[0] + a[1] * a[1] + a[2] * a[2] + a[3] * a[3] + b[0] * b[0] + b[1] * b[1] + b[2] * b[2] + b[3] * b[3];
            ss += __shfl_xor(ss, 16); ss += __shfl_xor(ss, 32);
            part[bj][ai][m] = ss;
            if (fq == 0) red[((wid * 2 + bj) * 8 + ai * 4 + m) * 16 + fr] = ss;
          }
      __syncthreads();
#pragma unroll
      for (int bj = 0; bj < 2; ++bj) {
        const int head = bj * 2 + (wc >> 1);
        const float* gp = gain + head * ghs + (wc & 1) * 32 + 8 * fq;
        g[bj][0] = *(const f32x4*)gp * scale; g[bj][1] = *(const f32x4*)(gp + 4) * scale;
#pragma unroll
        for (int ai = 0; ai < 2; ++ai)
#pragma unroll
          for (int m = 0; m < 4; ++m) {
            const float tot = part[bj][ai][m] + red[(((wid ^ 1) * 2 + bj) * 8 + ai * 4 + m) * 16 + fr];
            f[bj][ai][m] *= rsqrtf(tot * (1.0f / 64.0f) + 1e-6f);
          }
      }
    }
    if (mode == 3) {
#pragma unroll
      for (int ai = 0; ai < 2; ++ai)
#pragma unroll
        for (int m = 0; m < 4; ++m) {
          const f32x4 u0 = acc[ai][0][m][0], u1 = acc[ai][0][m][1], g0 = acc[ai][1][m][0], g1 = acc[ai][1][m][1];
          u32x4 pq;
          pq[0] = pk_bf16(u0[0] * silu_f(g0[0]), u0[1] * silu_f(g0[1])); pq[1] = pk_bf16(u0[2] * silu_f(g0[2]), u0[3] * silu_f(g0[3]));
          pq[2] = pk_bf16(u1[0] * silu_f(g1[0]), u1[1] * silu_f(g1[1])); pq[3] = pk_bf16(u1[2] * silu_f(g1[2]), u1[3] * silu_f(g1[3]));
          *(u32x4*)(ug + (size_t)(row0 + ai * HALF + m * 16) * 256 + ugc + (col0 & 127)) = pq;
        }
      return;
    }
    const bool silu = mode == 1;
#pragma unroll
    for (int ai = 0; ai < 2; ++ai)
#pragma unroll
      for (int m = 0; m < 4; ++m)
#pragma unroll
        for (int bj = 0; bj < 2; ++bj) {
          f32x4 v0 = acc[ai][bj][m][0], v1 = acc[ai][bj][m][1];
          if (mode == 2) { v0 = v0 * g[bj][0] * f[bj][ai][m]; v1 = v1 * g[bj][1] * f[bj][ai][m]; }
          if (silu) {
#pragma unroll
            for (int j = 0; j < 4; ++j) { v0[j] = silu_f(v0[j]); v1[j] = silu_f(v1[j]); }
          }
          u32x4 pk; pk[0] = pk_bf16(v0[0], v0[1]); pk[1] = pk_bf16(v0[2], v0[3]); pk[2] = pk_bf16(v1[0], v1[1]); pk[3] = pk_bf16(v1[2], v1[3]);
          *(u32x4*)(O + (size_t)(row0 + ai * HALF + m * 16) * ldo + col0 + bj * HALF) = pk;
        }
    if (mode == 2) __syncthreads();
  }
};

struct EpiOut {
  float* out; const float* x;
  DI void init(f32x4 (&acc)[2][2][4][2], int row0, int col0) const {
    const unsigned voff = ((unsigned)row0 * 1024u + (unsigned)col0) * 4u;
#pragma unroll
    for (int ai = 0; ai < 2; ++ai)
#pragma unroll
      for (int m = 0; m < 4; ++m) {
        const char* rb = (const char*)x + (size_t)(ai * HALF + m * 16) * 4096;
#pragma unroll
        for (int bj = 0; bj < 2; ++bj)
#pragma unroll
          for (int n = 0; n < 2; ++n) acc[ai][bj][m][n] = *(const f32x4*)(rb + voff + (bj * HALF + 4 * n) * 4);
      }
  }
  DI void operator()(f32x4 (&acc)[2][2][4][2], int row0, int col0) const {
    unsigned voff = ((unsigned)row0 * 1024u + (unsigned)col0) * 4u;
    asm volatile("" : "+v"(voff));
#pragma unroll
    for (int ai = 0; ai < 2; ++ai)
#pragma unroll
      for (int m = 0; m < 4; ++m) {
        char* rb = (char*)out + (size_t)(ai * HALF + m * 16) * 4096;
#pragma unroll
        for (int bj = 0; bj < 2; ++bj)
#pragma unroll
          for (int n = 0; n < 2; ++n) *(f32x4*)(rb + voff + (bj * HALF + 4 * n) * 4) = acc[ai][bj][m][n];
      }
  }
};

DI void tile_order(int L, int nM, int nN, int& pm, int& pn) {
  const int nwg = nM * nN;
  int wgid = L; { const int q = nwg / 8, r = nwg % 8, xcd = wgid % 8, off = wgid / 8; wgid = (xcd < r ? xcd * (q + 1) : r * (q + 1) + (xcd - r) * q) + off; }
  const int nig = 8 * nN, gid = wgid / nig, fm = gid * 8, gsz = (nM - fm) < 8 ? (nM - fm) : 8;
  pm = fm + ((wgid % nig) % gsz); pn = (wgid % nig) / gsz;
}

constexpr int NTAIL = 72;
DI void phase_gemm1(const Params& p, char* smem, const XcdBarrier& xb) {
  constexpr int NMAIN = 64 * 12;
  const int G = gridDim.x;
  const int nmain = (NMAIN + G - 1) / G;
  for (int k = 0; k <= nmain; ++k) {
    if (k == nmain) xcd_barrier(xb);
    for (int it = (k < nmain ? blockIdx.x + k * G : blockIdx.x); it < (k < nmain ? min(NMAIN, (k + 1) * G) : NTAIL); it += G) {
      bool main_t = true; int pm, pn;
      if (k < nmain) tile_order(it, 64, 12, pm, pn);
      else if (it < 64) { pm = it; pn = 12; }
      else { main_t = false; pm = (it - 64) >> 1; pn = (it - 64) & 1; }
      int mode = 0; const float* gain = p.aq_gain; int ghs = 0; float scale = 1.0f;
      if (main_t) {
        if (pn == 1) { mode = 2; gain = p.gv_gain; ghs = 64; }
        else if (pn == 0 || pn == 2) mode = 3;
        else if (pn == 9 || pn == 10 || pn == 12) mode = 1;
        else if (pn == 3 || pn == 4) { mode = 2; gain = p.aq_gain; scale = QSCALE; }
        else if (pn == 5 || pn == 6) { mode = 2; gain = p.ak_gain; }
        else if (pn == 11) { mode = 2; gain = p.mq_gain; scale = QSCALE; }
      } else if (pn == 0) { mode = 2; gain = p.mk_gain; }
      const EpiProj e{main_t ? p.proj : p.memkv, main_t ? IN_W : 512, mode, gain, ghs, scale, smem, p.ug, pn == 2 ? 128 : 0};
      gemm256<1024>(main_t ? p.xb : p.memb, main_t ? p.wt_in : p.wt_mem, pm * 256, pn * 256, smem, e);
    }
  }
}

DI void phase_gemm2(const Params& p, char* smem) {
  constexpr int NT = 64 * 4;
  const EpiOut e{p.out, p.x};
  for (int it = blockIdx.x; it < NT; it += gridDim.x) { int pm, pn; tile_order(it, 64, 4, pm, pn); gemm256<1024>(p.mix, p.wt_out, pm * 256, pn * 256, smem, e); }
}

DI u32x4 headnorm_chunk(u32x4 v, const float* gain8, float scale) {
  float f[8];
#pragma unroll
  for (int e = 0; e < 4; ++e) { f[2 * e] = bf_lo(v[e]); f[2 * e + 1] = bf_hi(v[e]); }
  float ss = 0.f;
#pragma unroll
  for (int e = 0; e < 8; ++e) ss += f[e] * f[e];
  ss += __shfl_xor(ss, 1); ss += __shfl_xor(ss, 2); ss += __shfl_xor(ss, 4);
  const float hn = rsqrtf(ss * (1.0f / 64.0f) + 1e-6f) * scale;
  const f32x4 g0 = *(const f32x4*)gain8, g1 = *(const f32x4*)(gain8 + 4);
  u32x4 r;
  r[0] = pk_bf16(f[0] * hn * g0[0], f[1] * hn * g0[1]); r[1] = pk_bf16(f[2] * hn * g0[2], f[3] * hn * g0[3]);
  r[2] = pk_bf16(f[4] * hn * g1[0], f[5] * hn * g1[1]); r[3] = pk_bf16(f[6] * hn * g1[2], f[7] * hn * g1[3]);
  return r;
}

constexpr int LDT = 72;
struct AttnDesc {
  const bf16_t* qp; long qs;
  const bf16_t* base; long koff, voff, ks;
  int jmin;
};
template <int NCH> struct AttnRegs { u32x4 kr[NCH], vr[NCH], qr[2][2]; };
template <int NCH> DI void attn_load(const AttnDesc& d, AttnRegs<NCH>& R) {
  const int tid = tid_opaque(), lane = tid & 63, w = tid >> 6, fr = lane & 15, fq = lane >> 4;
#pragma unroll
  for (int i = 0; i < NCH; ++i) {
    const int c = tid + NTHREADS * i, j = c >> 3, ch = (c & 7) * 8;
    if (j >= d.jmin) { R.kr[i] = *(const u32x4*)(d.base + (d.koff + (long)j * d.ks + ch)); R.vr[i] = *(const u32x4*)(d.base + (d.voff + (long)j * d.ks + ch)); }
  }
#pragma unroll
  for (int qt = 0; qt < 2; ++qt)
#pragma unroll
    for (int k2 = 0; k2 < 2; ++k2) R.qr[qt][k2] = *(const u32x4*)(d.qp + (long)(32 * w + 16 * qt + fr) * d.qs + k2 * 32 + fq * 8);
}
template <int NCH> DI void attn_stage(char* smem, int jmin, const AttnRegs<NCH>& R, bf16x8 (&qf)[2][2]) {
  const int tid = tid_opaque();
  bf16_t* Ks = (bf16_t*)smem; bf16_t* Vs = (bf16_t*)(smem + NCH * 64 * LDT * 2);
#pragma unroll
  for (int i = 0; i < NCH; ++i) {
    const int c = tid + NTHREADS * i, j = c >> 3, ch = (c & 7) * 8;
    if (j >= jmin) { *(u32x4*)(Ks + j * LDT + ch) = R.kr[i]; *(u32x4*)(Vs + j * LDT + ch) = R.vr[i]; }
  }
#pragma unroll
  for (int qt = 0; qt < 2; ++qt)
#pragma unroll
    for (int k2 = 0; k2 < 2; ++k2) qf[qt][k2] = __builtin_bit_cast(bf16x8, R.qr[qt][k2]);
}
template <int NCH> DI void attn_compute(char* smem, const bf16x8 (&qf)[2][2], int jmin, bool masked, float bound2, bf16_t* op, long os, float* lp, long ls, const bf16_t* gp, long gs) {
  const int tid = tid_opaque(), lane = tid & 63, w = tid >> 6, fr = lane & 15, fq = lane >> 4;
  LDS3 bf16_t* Ks = (LDS3 bf16_t*)smem; LDS3 bf16_t* Vs = (LDS3 bf16_t*)(smem + NCH * 64 * LDT * 2);
  f32x4 o[2][4], ol[2];
#pragma unroll
  for (int qt = 0; qt < 2; ++qt) {
    ol[qt] = (f32x4){0.f, 0.f, 0.f, 0.f};
#pragma unroll
    for (int dt = 0; dt < 4; ++dt) o[qt][dt] = (f32x4){0.f, 0.f, 0.f, 0.f};
  }
  const int jt_lo = masked ? (w > (jmin >> 5) ? w : (jmin >> 5)) : 0;
  const int jt_hi = masked ? w + 5 : 8;
  const int qq = (lane & 15) >> 2, pp = lane & 3;
  const float nb = -bound2;
  const bf16x8 ones = {0x3F80, 0x3F80, 0x3F80, 0x3F80, 0x3F80, 0x3F80, 0x3F80, 0x3F80};
  for (int jt = jt_lo; jt < jt_hi; ++jt) {
    f32x4 s[2][2];
#pragma unroll
    for (int kt = 0; kt < 2; ++kt) {
      s[0][kt] = (f32x4){nb, nb, nb, nb}; s[1][kt] = (f32x4){nb, nb, nb, nb};
#pragma unroll
      for (int k2 = 0; k2 < 2; ++k2) {
        const bf16x8 kf = *(const LDS3 bf16x8*)(Ks + (32 * jt + 16 * kt + fr) * LDT + k2 * 32 + fq * 8);
        s[0][kt] = mfma16(kf, qf[0][k2], s[0][kt]);
        s[1][kt] = mfma16(kf, qf[1][k2], s[1][kt]);
      }
    }
    bf16x8 pf[2];
    const bool edge = masked && (jt == w || jt == w + 4);
#pragma unroll
    for (int qt = 0; qt < 2; ++qt) {
      float pv[8];
#pragma unroll
      for (int kt = 0; kt < 2; ++kt)
#pragma unroll
        for (int r = 0; r < 4; ++r) pv[kt * 4 + r] = __builtin_amdgcn_exp2f(s[qt][kt][r]);
      if (edge) {
        const int iq = 32 * w + 16 * qt + fr;
#pragma unroll
        for (int kt = 0; kt < 2; ++kt)
#pragma unroll
          for (int r = 0; r < 4; ++r) {
            const int j = 32 * jt + 16 * kt + fq * 4 + r;
            if (!(j >= iq && j <= iq + 128)) pv[kt * 4 + r] = 0.f;
          }
      }
      u32x4 pk; pk[0] = pk_bf16(pv[0], pv[1]); pk[1] = pk_bf16(pv[2], pv[3]); pk[2] = pk_bf16(pv[4], pv[5]); pk[3] = pk_bf16(pv[6], pv[7]);
      pf[qt] = __builtin_bit_cast(bf16x8, pk);
    }
    ol[0] = mfma16(ones, pf[0], ol[0]); ol[1] = mfma16(ones, pf[1], ol[1]);
#pragma unroll
    for (int dt = 0; dt < 4; ++dt) {
      const s16x4 lo = __builtin_amdgcn_ds_read_tr16_b64_v4i16((LDS3 s16x4*)(Vs + (32 * jt + fq * 4 + qq) * LDT + dt * 16 + 4 * pp));
      const s16x4 hi = __builtin_amdgcn_ds_read_tr16_b64_v4i16((LDS3 s16x4*)(Vs + (32 * jt + 16 + fq * 4 + qq) * LDT + dt * 16 + 4 * pp));
      const bf16x8 vf = __builtin_shufflevector(lo, hi, 0, 1, 2, 3, 4, 5, 6, 7);
      o[0][dt] = mfma16(vf, pf[0], o[0][dt]);
      o[1][dt] = mfma16(vf, pf[1], o[1][dt]);
    }
  }
#pragma unroll
  for (int qt = 0; qt < 2; ++qt) {
    const long iq = 32 * w + 16 * qt + fr;
    const float l = ol[qt][0];
    if (lp) {
      if (fq == 0) lp[iq * ls] = l;
#pragma unroll
      for (int dt = 0; dt < 4; ++dt) {
        u32x2 pk; pk[0] = pk_bf16(o[qt][dt][0], o[qt][dt][1]); pk[1] = pk_bf16(o[qt][dt][2], o[qt][dt][3]);
        *(u32x2*)(op + iq * os + dt * 16 + fq * 4) = pk;
      }
    } else {
      const float inv = __builtin_amdgcn_rcpf(l);
#pragma unroll
      for (int dt = 0; dt < 4; ++dt) {
        const u32x2 g = *(const u32x2*)(gp + iq * gs + dt * 16 + fq * 4);
        u32x2 pk;
        pk[0] = pk_bf16(o[qt][dt][0] * inv * bf_lo(g[0]), o[qt][dt][1] * inv * bf_hi(g[0]));
        pk[1] = pk_bf16(o[qt][dt][2] * inv * bf_lo(g[1]), o[qt][dt][3] * inv * bf_hi(g[1]));
        *(u32x2*)(op + iq * os + dt * 16 + fq * 4) = pk;
      }
    }
  }
}

constexpr int LDV = 136;
DI void gmlp_item(const Params& p, char* smem, int b, int c, int h) {
  const int tid = tid_opaque(), lane = tid & 63, w = tid >> 6, fr = lane & 15, fq = lane >> 4;
  const size_t tok0 = (size_t)b * SEQ + c * 128;
  bf16_t* vT = (bf16_t*)smem;
  const int t = 16 * w + fr;
  const bf16_t* wrow = p.wsb + (size_t)h * 16384 + (size_t)t * 128 + fq * 8;
  bf16x8 af[4];
#pragma unroll
  for (int k3 = 0; k3 < 4; ++k3) af[k3] = *(const bf16x8*)(wrow + k3 * 32);
  const float bias = p.gmlp_b[h * 128 + t];
  const bool oddq = fq & 1;
  const int dbase = (oddq ? 16 : 0) + (fq & 2) * 4;
  const bf16_t* ugrow = p.ug + (tok0 + t) * 256 + h * 64 + dbase;
  u32x4 uu[2];
#pragma unroll
  for (int np = 0; np < 2; ++np) uu[np] = *(const u32x4*)(ugrow + np * 32);
#pragma unroll
  for (int i = 0; i < 2; ++i) {
    const int ci = tid + NTHREADS * i, s = ci >> 3, ch = (ci & 7) * 8;
    *(u32x4*)(vT + s * LDT + ch) = *(const u32x4*)(p.proj + (tok0 + s) * IN_W + C_GV + h * 64 + ch);
  }
  __syncthreads();
  f32x4 acc[4];
#pragma unroll
  for (int n = 0; n < 4; ++n) acc[n] = (f32x4){0.f, 0.f, 0.f, 0.f};
  LDS3 bf16_t* vS = (LDS3 bf16_t*)smem;
  const int qq = (lane & 15) >> 2, pp = lane & 3;
#pragma unroll
  for (int k3 = 0; k3 < 4; ++k3) {
    if (k3 <= (w >> 1)) {
#pragma unroll
      for (int n = 0; n < 4; ++n) {
        const s16x4 blo = __builtin_amdgcn_ds_read_tr16_b64_v4i16((LDS3 s16x4*)(vS + (k3 * 32 + fq * 8 + qq) * LDT + n * 16 + 4 * pp));
        const s16x4 bhi = __builtin_amdgcn_ds_read_tr16_b64_v4i16((LDS3 s16x4*)(vS + (k3 * 32 + fq * 8 + 4 + qq) * LDT + n * 16 + 4 * pp));
        const bf16x8 bfr = __builtin_shufflevector(blo, bhi, 0, 1, 2, 3, 4, 5, 6, 7);
        acc[n] = mfma16(bfr, af[k3], acc[n]);
      }
    }
  }
  {
    bf16_t* orow = p.mix + (tok0 + t) * 1024 + h * 64 + dbase;
#pragma unroll
    for (int np = 0; np < 2; ++np) {
      const f32x4 own = oddq ? acc[2 * np + 1] : acc[2 * np];
      const f32x4 snd = oddq ? acc[2 * np] : acc[2 * np + 1];
      f32x4 rcv;
#pragma unroll
      for (int r = 0; r < 4; ++r) rcv[r] = __shfl_xor(snd[r], 16);
      const f32x4 lo = oddq ? rcv : own, hi = oddq ? own : rcv;
      const u32x4 u = uu[np];
      u32x4 pk;
      pk[0] = pk_bf16(bf_lo(u[0]) * (lo[0] + bias), bf_hi(u[0]) * (lo[1] + bias)); pk[1] = pk_bf16(bf_lo(u[1]) * (lo[2] + bias), bf_hi(u[1]) * (lo[3] + bias));
      pk[2] = pk_bf16(bf_lo(u[2]) * (hi[0] + bias), bf_hi(u[2]) * (hi[1] + bias)); pk[3] = pk_bf16(bf_lo(u[3]) * (hi[2] + bias), bf_hi(u[3]) * (hi[3] + bias));
      *(u32x4*)(orow + np * 32) = pk;
    }
  }
  __syncthreads();
}

struct DilItem { AttnDesc d; long tokq0; int dil, cfg, h; };
DI DilItem dil_item(const Params& p, int it) {
  DilItem I;
  const int idx = it & 15, cfg = (it >> 4) % 3, bh = it / 48, h = bh & 7, b = bh >> 3;
  const int sh = cfg * 2, dil = 1 << sh;
  const int r = idx & (dil - 1), nb2 = idx >> sh;
  const long tokq0 = (long)b * SEQ + (long)(256 * nb2) * dil + r;
  const long tokk0 = tokq0 - 128L * dil;
  I.d.qp = p.proj + tokq0 * IN_W + C_AQ + h * 64; I.d.qs = (long)dil * IN_W;
  I.d.base = p.proj; I.d.koff = tokk0 * IN_W + C_AK + h * 64; I.d.voff = tokk0 * IN_W + C_AV + h * 64; I.d.ks = (long)dil * IN_W;
  I.d.jmin = nb2 == 0 ? 128 : 0;
  I.tokq0 = tokq0; I.dil = dil; I.cfg = cfg; I.h = h;
  return I;
}

constexpr int TAIL_COST_ITEMS = 5;
DI void phase_mix(const Params& p, char* smem, volatile LDS3 unsigned* st) {
  constexpr int N_DIL = BATCH * 8 * 3 * 16, N_G = BATCH * 32 * 4;
  const float bound_a = p.bounds[0];
  const int G = gridDim.x;
  {
    int first, step, end; bool xmap = false;
    int x = 0;
    if (G == 256) {
      xmap = true; x = blockIdx.x & 7;
      const int j = blockIdx.x >> 3;
      constexpr int PER_X = N_DIL / 8, NB = NTAIL / 8, NAB = 32 - NB;
      constexpr int NA = ((PER_X + NB * TAIL_COST_ITEMS) * NAB + 16) / 32 < PER_X ? ((PER_X + NB * TAIL_COST_ITEMS) * NAB + 16) / 32 : PER_X;
      if (j >= NB) { first = j - NB; step = NAB; end = NA; } else { first = NA + j; step = NB; end = PER_X; }
    } else { first = blockIdx.x; step = G; end = N_DIL; }
    auto item_of = [&](int v) { return xmap ? (x + 8 * (v / 48)) * 48 + (v % 48) : v; };
    AttnRegs<6> R;
    int it = first;
    DilItem cur = dil_item(p, item_of(it < end ? it : 0));
    if (it < end) attn_load<6>(cur.d, R);
    for (; it < end; it += step) {
      bf16x8 qf[2][2];
      attn_stage<6>(smem, cur.d.jmin, R, qf);
      __syncthreads();
      const DilItem me = cur;
      if (it + step < end) { cur = dil_item(p, item_of(it + step)); attn_load<6>(cur.d, R); }
      attn_compute<6>(smem, qf, me.d.jmin, true, bound_a,
                   p.opart + ((size_t)me.cfg * NTOK + me.tokq0) * 512 + me.h * 64, (long)me.dil * 512, p.lpart + ((size_t)me.cfg * NTOK + me.tokq0) * 8 + me.h, (long)me.dil * 8, nullptr, 0);
      __syncthreads();
    }
  }
  {
    unsigned* ctr = p.bar + XCD_BAR_WORDS;
    const int tid = threadIdx.x;
    if (tid == 0) st[2] = atomicAdd(ctr, 1u);
    __syncthreads();
    int t = __builtin_amdgcn_readfirstlane((int)st[2]);
    while (t < N_G) {
      unsigned nx = 0u;
      if (tid == 0) nx = atomicAdd(ctr, 1u);
      const int h = t & 3, c = (t >> 2) & 31, b = t >> 7;
      gmlp_item(p, smem, b, c, h);
      if (tid == 0) st[2] = nx;
      __syncthreads();
      t = __builtin_amdgcn_readfirstlane((int)st[2]);
    }
  }
}

DI void phase_mem(const Params& p, char* smem) {
  constexpr int N_PAIR = BATCH * 4 * 16;
  const float bound_m = p.bounds[1];
  for (int pr = blockIdx.x; pr < N_PAIR; pr += gridDim.x) {
    const int tile = (pr & 15) * 2, mh = (pr >> 4) & 3, b = pr >> 6;
    const long tok0 = (long)b * SEQ + tile * 128;
    AttnDesc d; d.qp = p.proj + tok0 * IN_W + C_MQ + mh * 64; d.qs = IN_W; d.base = p.memkv; d.koff = (long)b * MEM_LEN * 512 + mh * 64; d.voff = d.koff + 256; d.ks = 512; d.jmin = 0;
    AttnRegs<4> R; bf16x8 qf[2][2];
    attn_load<4>(d, R);
    attn_stage<4>(smem, 0, R, qf);
    __syncthreads();
    attn_compute<4>(smem, qf, 0, false, bound_m, p.mix + tok0 * 1024 + 768 + mh * 64, 1024, nullptr, 0, p.proj + tok0 * IN_W + C_MG + mh * 64, IN_W);
    __syncthreads();
  }
}

DI void phase_combine(const Params& p) {
  constexpr int NCH = NTOK * 64;
  for (int ci = blockIdx.x * NTHREADS + tid_opaque(); ci < NCH; ci += gridDim.x * NTHREADS) {
    const int tok = ci >> 6, col = (ci & 63) * 8, h = col >> 6;
    float l = 0.f; float o[8] = {0.f, 0.f, 0.f, 0.f, 0.f, 0.f, 0.f, 0.f};
#pragma unroll
    for (int cfg = 0; cfg < 3; ++cfg) {
      l += p.lpart[((size_t)cfg * NTOK + tok) * 8 + h];
      const u32x4 v = *(const u32x4*)(p.opart + ((size_t)cfg * NTOK + tok) * 512 + col);
#pragma unroll
      for (int e = 0; e < 4; ++e) { o[2 * e] += bf_lo(v[e]); o[2 * e + 1] += bf_hi(v[e]); }
    }
    const u32x4 g = *(const u32x4*)(p.proj + (size_t)tok * IN_W + C_AG + col);
    const float inv = __builtin_amdgcn_rcpf(l);
    u32x4 pk;
#pragma unroll
    for (int e = 0; e < 4; ++e) pk[e] = pk_bf16(o[2 * e] * inv * bf_lo(g[e]), o[2 * e + 1] * inv * bf_hi(g[e]));
    *(u32x4*)(p.mix + (size_t)tok * 1024 + 256 + col) = pk;
  }
}


__global__ void __launch_bounds__(NTHREADS, 2) fwd_kernel(Params p, int use_cg) {
  extern __shared__ __attribute__((aligned(16))) char smem[];
  __shared__ uint4 xb_words;
  if (threadIdx.x == 0) xb_words = make_uint4(0u, 0u, 0u, 0u);
  __syncthreads();
  XcdBarrier xb = xcd_barrier_post(p.bar, (volatile LDS3 unsigned*)&xb_words);
  if (use_cg) cg::this_grid().sync();
  phase_prep(p, smem);
  xcd_barrier(xb);
  phase_gemm1(p, smem, xb);
  phase_mix(p, smem, (volatile LDS3 unsigned*)&xb_words);
  xcd_barrier(xb);
  phase_mem(p, smem);
  phase_combine(p);
  xcd_barrier(xb);
  phase_gemm2(p, smem);
}

extern "C" void kernel_launch(void* const* d_in, const int* in_sizes, int n_in, void* d_out, int out_size, void* d_ws, size_t ws_size, hipStream_t stream) {
  static int grid_blocks = 0;
  if (!grid_blocks) {
    int dev = 0, cus = 0, per_cu = 0;
    hipGetDevice(&dev);
    hipDeviceGetAttribute(&cus, hipDeviceAttributeMultiprocessorCount, dev);
    hipFuncSetAttribute((const void*)fwd_kernel, hipFuncAttributeMaxDynamicSharedMemorySize, SMEM_BYTES);
    hipOccupancyMaxActiveBlocksPerMultiprocessor(&per_cu, fwd_kernel, NTHREADS, SMEM_BYTES);
    if (per_cu != 1) per_cu = 1;
    grid_blocks = cus * per_cu;
  }
  Params p{};
  p.x = (const float*)d_in[0]; p.mem = (const float*)d_in[1]; p.norm_gain = (const float*)d_in[2]; p.w_in = (const float*)d_in[3];
  p.gv_gain = (const float*)d_in[4]; p.w_s = (const float*)d_in[5]; p.gmlp_b = (const float*)d_in[6]; p.aq_gain = (const float*)d_in[7];
  p.ak_gain = (const float*)d_in[8]; p.mem_norm_gain = (const float*)d_in[9]; p.w_mem_kv = (const float*)d_in[10]; p.mq_gain = (const float*)d_in[11];
  p.mk_gain = (const float*)d_in[12]; p.w_out = (const float*)d_in[13];
  p.out = (float*)d_out;
  char* ws = (char*)d_ws; size_t off = 0;
  auto take = [&](size_t bytes) { char* r = ws + off; off += (bytes + 255) & ~(size_t)255; return r; };
  p.wt_in = (bf16_t*)take((size_t)IN_W * 1024 * 2);
  p.wt_out = (bf16_t*)take((size_t)1024 * 1024 * 2);
  p.wt_mem = (bf16_t*)take((size_t)512 * 1024 * 2);
  p.wsb = (bf16_t*)take((size_t)4 * 128 * 128 * 2);
  p.xb = (bf16_t*)take((size_t)NTOK * 1024 * 2);
  p.memb = (bf16_t*)take((size_t)NMEM * 1024 * 2);
  p.proj = (bf16_t*)take((size_t)NTOK * IN_W * 2);
  p.memkv = (bf16_t*)take((size_t)NMEM * 512 * 2);
  p.opart = (bf16_t*)take((size_t)3 * NTOK * 512 * 2);
  p.mix = (bf16_t*)take((size_t)NTOK * 1024 * 2);
  p.ug = (bf16_t*)take((size_t)NTOK * 256 * 2);
  p.lpart = (float*)take((size_t)3 * NTOK * 8 * 4);
  p.bounds = (float*)take(256);
  p.bar = (unsigned*)take((size_t)(XCD_BAR_WORDS + 64) * 4);
  if (off > ws_size) { fprintf(stderr, "workspace too small: need %zu have %zu\n", off, ws_size); return; }
  hipMemsetAsync(p.bar, 0, (size_t)(XCD_BAR_WORDS + 64) * 4, stream);
  int use_cg = 0;
  void* args[] = {&p, &use_cg};
  hipError_t e = hipLaunchCooperativeKernel((void*)fwd_kernel, dim3(grid_blocks), dim3(NTHREADS), args, SMEM_BYTES, stream);
  if (e != hipSuccess) fprintf(stderr, "cooperative launch failed: %s (grid %d)\n", hipGetErrorString(e), grid_blocks);
}
```

```cpp
#include <hip/hip_runtime.h>
#include <hip/hip_cooperative_groups.h>
#include <cstdio>
namespace cg = cooperative_groups;

typedef unsigned short bf16_t;
typedef short bf16x8 __attribute__((ext_vector_type(8)));
typedef short s16x4 __attribute__((ext_vector_type(4)));
typedef float f32x4 __attribute__((ext_vector_type(4)));
typedef unsigned u32x4 __attribute__((ext_vector_type(4)));
typedef unsigned u32x2 __attribute__((ext_vector_type(2)));
#define DI __device__ __forceinline__
#define LDS3 __attribute__((address_space(3)))

constexpr int NTHREADS = 512;
constexpr int D_MODEL = 1024, SEQ = 4096, BATCH = 4, NTOK = BATCH * SEQ, MEM_LEN = 256, NMEM = BATCH * MEM_LEN;
constexpr int IN_W = 3328;
constexpr int C_GU = 0, C_GV = 256, C_GG = 512, C_AQ = 768, C_AK = 1280, C_AV = 1792, C_AG = 2304, C_MQ = 2816, C_MG = 3072;
constexpr int SMEM_BYTES = 131072;
constexpr float LOG2E = 1.4426950408889634f;
constexpr float QSCALE = 0.125f * LOG2E;

struct Params {
  const float *x, *mem, *norm_gain, *w_in, *gv_gain, *w_s, *gmlp_b, *aq_gain, *ak_gain, *mem_norm_gain, *w_mem_kv, *mq_gain, *mk_gain, *w_out;
  float* out;
  bf16_t *wt_in, *wt_out, *wt_mem, *wsb, *xb, *memb, *proj, *memkv, *opart, *mix, *ug;
  float *lpart, *bounds;
  unsigned* bar;
};

typedef __bf16 bf16v2 __attribute__((ext_vector_type(2)));
typedef float f32x2 __attribute__((ext_vector_type(2)));
DI unsigned pk_bf16(float lo, float hi) { const f32x2 f = {lo, hi}; return __builtin_bit_cast(unsigned, __builtin_convertvector(f, bf16v2)); }
DI float bf_lo(unsigned u) { return __uint_as_float(u << 16); }
DI float bf_hi(unsigned u) { return __uint_as_float(u & 0xffff0000u); }
DI float silu_f(float v) { return v * __builtin_amdgcn_rcpf(1.0f + __builtin_amdgcn_exp2f(-LOG2E * v)); }
DI int tid_opaque() { int t = threadIdx.x; asm volatile("" : "+v"(t)); return t; }
DI f32x4 mfma16(bf16x8 a, bf16x8 b, f32x4 c) { return __builtin_amdgcn_mfma_f32_16x16x32_bf16(a, b, c, 0, 0, 0); }

#define XB_TMO      128
#define XB_XCNT(j)  (256  + 64 * (j))
#define XB_XSUB(j)  (1280 + 64 * (j))
#define XB_XGEN(j)  (2304 + 64 * (j))
#define XB_TOP      3328
#define XB_TOPGEN   3392
#define XCD_BAR_WORDS 3456
#define XB_SPIN_CAP (1u << 22)
DI unsigned xb_ld(unsigned* p) { return __hip_atomic_load(p, __ATOMIC_RELAXED, __HIP_MEMORY_SCOPE_AGENT); }
DI unsigned xb_add(unsigned* p, unsigned v) { return __hip_atomic_fetch_add(p, v, __ATOMIC_RELAXED, __HIP_MEMORY_SCOPE_AGENT); }
DI unsigned xb_xcc_id() { return (unsigned)__builtin_amdgcn_s_getreg((3 << 11) | 20) & 0xFu; }
#define XB_SPIN(cond, bar) do { unsigned _sp = 0; while (cond) { __builtin_amdgcn_s_sleep(1); \
    if ((++_sp & 255u) == 0u) { if (xb_ld(&(bar)[XB_TMO])) break; if (_sp > XB_SPIN_CAP) { atomicAdd(&(bar)[XB_TMO], 1u); break; } } } } while (0)
struct XcdBarrier { unsigned* bar; unsigned x; volatile LDS3 unsigned* st; };
DI XcdBarrier xcd_barrier_post(unsigned* bar, volatile LDS3 unsigned* st) {
  XcdBarrier b; b.bar = bar; b.x = xb_xcc_id(); b.st = st;
  if (threadIdx.x == 0) (void)xb_add(&bar[XB_XCNT(b.x)], 1u);
  return b;
}
DI void xcd_barrier_complete(unsigned* bar, unsigned x, unsigned& nloc, unsigned& nx) {
  const unsigned G = gridDim.x * gridDim.y * gridDim.z;
  unsigned sum, cnt, mine, sp = 0u;
  for (;;) {
    sum = 0u; cnt = 0u; mine = 0u;
#pragma unroll
    for (unsigned j = 0; j < 16; ++j) { const unsigned c = xb_ld(&bar[XB_XCNT(j)]); sum += c; cnt += (c > 0u) ? 1u : 0u; mine = (j == x) ? c : mine; }
    if (sum == G) break;
    __builtin_amdgcn_s_sleep(1);
    if ((++sp & 255u) == 0u) { if (xb_ld(&bar[XB_TMO])) break; if (sp > XB_SPIN_CAP) { atomicAdd(&bar[XB_TMO], 1u); break; } }
  }
  nloc = mine > 0u ? mine : 1u; nx = cnt > 0u ? cnt : 1u;
}
DI void xcd_barrier(const XcdBarrier& b) {
  asm volatile("s_waitcnt vmcnt(0)" ::: "memory");
  __syncthreads();
  if (threadIdx.x == 0) {
    unsigned* bar = b.bar;
    __builtin_amdgcn_s_waitcnt(0);
    unsigned nloc = b.st[0], nx = b.st[1];
    if (nloc == 0u) { xcd_barrier_complete(bar, b.x, nloc, nx); b.st[0] = nloc; b.st[1] = nx; }
    const unsigned old = xb_add(&bar[XB_XSUB(b.x)], 1u);
    const unsigned gen = old / nloc;
    if (old + 1u == (gen + 1u) * nloc) {
      __builtin_amdgcn_fence(__ATOMIC_RELEASE, "agent");
      asm volatile("s_waitcnt vmcnt(0)" ::: "memory");
      const unsigned og = xb_add(&bar[XB_TOP], 1u);
      const unsigned tg = og / nx;
      if (og + 1u == (tg + 1u) * nx) xb_add(&bar[XB_TOPGEN], 1u);
      else XB_SPIN(xb_ld(&bar[XB_TOPGEN]) == tg, bar);
      __builtin_amdgcn_fence(__ATOMIC_ACQUIRE, "agent");
      xb_add(&bar[XB_XGEN(b.x)], 1u);
      asm volatile("s_waitcnt vmcnt(0)" ::: "memory");
    } else {
      XB_SPIN(xb_ld(&bar[XB_XGEN(b.x)]) == gen, bar);
      __builtin_amdgcn_fence(__ATOMIC_ACQUIRE, "agent");
      asm volatile("s_waitcnt vmcnt(0)" ::: "memory");
    }
  }
  __syncthreads();
}

DI void phase_prep(const Params& p, char* smem) {
  const int tid = threadIdx.x, lane = tid & 63, wid = tid >> 6;
  constexpr int T_IN = 16 * 52, T_OUT = 16 * 16, T_MEM = 16 * 8, NT = T_IN + T_OUT + T_MEM;
  constexpr int NR = (NTOK + NMEM) / 8, NW = 32;
  constexpr int TOTAL = NT + NR + NW + 1;
  {
    auto tile_desc = [&](int t, const float*& src, const float*& gain, bf16_t*& dst, int& N, int& tk, int& tn) {
      const bool a = t < T_IN, b = t < T_IN + T_OUT;
      src = a ? p.w_in : (b ? p.w_out : p.w_mem_kv);
      gain = a ? p.norm_gain : (b ? nullptr : p.mem_norm_gain);
      dst = a ? p.wt_in : (b ? p.wt_out : p.wt_mem);
      N = a ? IN_W : (b ? 1024 : 512);
      t -= a ? 0 : (b ? T_IN : T_IN + T_OUT);
      const int ntn = N >> 6; tk = t / ntn; tn = t % ntn;
    };
    float rv[8], rg[8];
    auto tile_load = [&](int t) {
      const float* src; const float* gain; bf16_t* dst; int N, tk, tn; tile_desc(t, src, gain, dst, N, tk, tn);
#pragma unroll
      for (int i = 0; i < 8; ++i) {
        const int idx = tid + NTHREADS * i, r = idx >> 6, c = idx & 63, k = tk * 64 + r;
        rv[i] = src[(size_t)k * N + tn * 64 + c];
        rg[i] = gain ? gain[k] : 1.0f;
      }
    };
    int it = blockIdx.x;
    if (it < NT) tile_load(it);
    float* tile = (float*)smem;
    for (; it < NT; it += gridDim.x) {
      const float* src; const float* gain; bf16_t* dst; int N, tk, tn; tile_desc(it, src, gain, dst, N, tk, tn);
#pragma unroll
      for (int i = 0; i < 8; ++i) { const int idx = tid + NTHREADS * i, r = idx >> 6, c = idx & 63; tile[r * 65 + c] = rv[i] * rg[i]; }
      __syncthreads();
      if (it + (int)gridDim.x < NT) tile_load(it + gridDim.x);
#pragma unroll
      for (int i = 0; i < 4; ++i) {
        const int idx = tid + NTHREADS * i, c = idx >> 5, r2 = (idx & 31) * 2;
        const int tnd = (src == p.w_in) ? ((tn == 2 || tn == 3) ? tn + 6 : ((tn == 8 || tn == 9) ? tn - 6 : tn)) : tn;
        *(unsigned*)(dst + (size_t)(tnd * 64 + c) * 1024 + tk * 64 + r2) = pk_bf16(tile[r2 * 65 + c], tile[(r2 + 1) * 65 + c]);
      }
      __syncthreads();
    }
  }
  for (int it = NT + blockIdx.x; it < TOTAL; it += gridDim.x) {
    if (false) {
    } else if (it < NT + NR) {
      const int row = (it - NT) * 8 + wid;
      const float* src; bf16_t* dst;
      if (row < NTOK) { src = p.x + (size_t)row * 1024; dst = p.xb + (size_t)row * 1024; }
      else { const int r2 = row - NTOK; src = p.mem + (size_t)r2 * 1024; dst = p.memb + (size_t)r2 * 1024; }
      f32x4 v[4]; float ss = 0.f;
#pragma unroll
      for (int i = 0; i < 4; ++i) { v[i] = ((const f32x4*)src)[i * 64 + lane]; ss += v[i][0] * v[i][0] + v[i][1] * v[i][1] + v[i][2] * v[i][2] + v[i][3] * v[i][3]; }
#pragma unroll
      for (int o = 32; o >= 1; o >>= 1) ss += __shfl_xor(ss, o);
      const float rn = rsqrtf(ss * (1.0f / 1024.0f) + 1e-6f);
#pragma unroll
      for (int i = 0; i < 4; ++i) { u32x2 pk; pk[0] = pk_bf16(v[i][0] * rn, v[i][1] * rn); pk[1] = pk_bf16(v[i][2] * rn, v[i][3] * rn); ((u32x2*)dst)[i * 64 + lane] = pk; }
    } else if (it < NT + NR + NW) {
      const int base = (it - NT - NR) * 2048 + tid * 4;
      const f32x4 v = *(const f32x4*)(p.w_s + base);
      const int t = (base >> 7) & 127, s = base & 127;
      u32x2 pk;
      pk[0] = pk_bf16(s <= t ? v[0] : 0.f, s + 1 <= t ? v[1] : 0.f);
      pk[1] = pk_bf16(s + 2 <= t ? v[2] : 0.f, s + 3 <= t ? v[3] : 0.f);
      *(u32x2*)(p.wsb + base) = pk;
    } else {
      if (wid == 0) {
        float a = fabsf(p.aq_gain[lane]), b = fabsf(p.ak_gain[lane]), c = fabsf(p.mq_gain[lane]), d = fabsf(p.mk_gain[lane]);
#pragma unroll
        for (int o = 32; o >= 1; o >>= 1) { a = fmaxf(a, __shfl_xor(a, o)); b = fmaxf(b, __shfl_xor(b, o)); c = fmaxf(c, __shfl_xor(c, o)); d = fmaxf(d, __shfl_xor(d, o)); }
        if (lane == 0) { p.bounds[0] = 8.0f * a * b * LOG2E; p.bounds[1] = 8.0f * c * d * LOG2E; }
      }
    }
  }
}

constexpr int BM = 256, BK = 64, HALF = 128, HT = HALF * BK;
DI int lds_byte(int r, int c) { const int st = (r >> 4) * 2 + (c >> 5), rr = r & 15, cc = c & 31, ob = rr * 64 + cc * 2; return st * 1024 + (ob ^ (((ob >> 9) & 1) << 5)); }
DI void stage_rc(int b, int& R, int& C) { const int st = b / 1024, sb = b % 1024, swz = sb ^ (((sb >> 9) & 1) << 5); R = (st >> 1) * 16 + swz / 64; C = (st & 1) * 32 + (swz % 64) / 2; }
DI int perm32(int rho) { const int n = rho >> 4, i = rho & 15; return 8 * (i >> 2) + 4 * n + (i & 3); }

template <int K, class Epi>
DI void gemm256(const bf16_t* __restrict__ A, const bf16_t* __restrict__ Bt, const int brow, const int bcol, char* smem, const Epi& epi) {
  LDS3 unsigned char* lds = (LDS3 unsigned char*)smem;
  const int tid = threadIdx.x, wid = __builtin_amdgcn_readfirstlane(tid >> 6), lane = tid & 63, wr = wid >> 2, wc = wid & 3, fr = lane & 15, fq = lane >> 4;
  constexpr int HTB = HT * 2;
  unsigned voffA[2], voffB[2];
#pragma unroll
  for (int i = 0; i < 2; ++i) { int R, C; stage_rc(tid * 16 + i * 8192, R, C); voffA[i] = (unsigned)(R * K + C) * 2u; voffB[i] = (unsigned)(((R & ~31) + perm32(R & 31)) * K + C) * 2u; }
  constexpr size_t kstep = (size_t)BK * 2, hstep = (size_t)HALF * K * 2;
  const unsigned ldsw = (unsigned)wid * 1024u;
  const int aoff = lds_byte(wr * 64 + fr, fq * 8), boff = lds_byte(wc * 32 + fr, fq * 8);
  const char* cA = (const char*)A + (size_t)brow * K * 2;
  const char* cB = (const char*)Bt + (size_t)bcol * K * 2;
#define SA(b, h) (((b) * 2 + (h)) * HTB)
#define SB(b, h) ((4 + (b) * 2 + (h)) * HTB)
#define STAGE(bufoff, gbase, voff) do { _Pragma("unroll") for (int _i = 0; _i < 2; ++_i) \
    __builtin_amdgcn_global_load_lds((const unsigned*)((const char*)(gbase) + (voff)[_i]), (LDS3 unsigned*)(lds + (bufoff) + ldsw + _i * 8192), 16, 0, 0); } while (0)
#define LDA(dst, b, h) do { _Pragma("unroll") for (int m = 0; m < 4; ++m) _Pragma("unroll") for (int k = 0; k < 2; ++k) dst[m][k] = *(const LDS3 bf16x8*)(lds + SA(b, h) + aoff + m * 2048 + k * 1024); } while (0)
#define LDB(dst, b, h) do { _Pragma("unroll") for (int n = 0; n < 2; ++n) _Pragma("unroll") for (int k = 0; k < 2; ++k) dst[n][k] = *(const LDS3 bf16x8*)(lds + SB(b, h) + boff + n * 2048 + k * 1024); } while (0)
#define MMA(ai, bj, At_, Bt_) do { __builtin_amdgcn_s_setprio(1); \
    _Pragma("unroll") for (int m = 0; m < 4; ++m) _Pragma("unroll") for (int n = 0; n < 2; ++n) _Pragma("unroll") for (int k = 0; k < 2; ++k) \
      acc[ai][bj][m][n] = __builtin_amdgcn_mfma_f32_16x16x32_bf16(Bt_[n][k], At_[m][k], acc[ai][bj][m][n], 0, 0, 0); \
    __builtin_amdgcn_s_setprio(0); } while (0)
#define WAIT_V(n) asm volatile("s_waitcnt vmcnt(" #n ")" ::: "memory")
#define WAIT_L(n) asm volatile("s_waitcnt lgkmcnt(" #n ")" ::: "memory")
#define BAR __builtin_amdgcn_s_barrier()
#define SCHED __builtin_amdgcn_sched_barrier(0)
  f32x4 acc[2][2][4][2];
  bf16x8 At[4][2], B0[2][2], B1[2][2];
  constexpr int nt = K / BK;
  WAIT_V(0);
  STAGE(SB(0, 0), cB, voffB); STAGE(SA(0, 0), cA, voffA); STAGE(SB(0, 1), cB + hstep, voffB); STAGE(SA(0, 1), cA + hstep, voffA);
  if (wr == 1) BAR;
  WAIT_V(4); BAR;
  STAGE(SB(1, 0), cB + kstep, voffB); STAGE(SA(1, 0), cA + kstep, voffA); STAGE(SB(1, 1), cB + hstep + kstep, voffB);
  WAIT_V(6); BAR;
  epi.init(acc, brow + wr * 64 + fr, bcol + wc * 32 + 8 * fq);
  for (int t = 0; t < nt - 2; t += 2) {
    const char* a1 = cA + (size_t)(t + 1) * kstep;
    const char* a2 = cA + (size_t)(t + 2) * kstep; const char* b2 = cB + (size_t)(t + 2) * kstep;
    const char* a3 = a2 + kstep; const char* b3 = b2 + kstep;
    LDB(B0, 0, 0); SCHED; LDA(At, 0, 0); STAGE(SA(1, 1), a1 + hstep, voffA);
    WAIT_L(8); BAR; WAIT_L(0); MMA(0, 0, At, B0); BAR; SCHED;
    LDB(B1, 0, 1); STAGE(SB(0, 0), b2, voffB);
    BAR; WAIT_L(0); MMA(0, 1, At, B1); BAR;
    LDA(At, 0, 1); STAGE(SA(0, 0), a2, voffA);
    BAR; WAIT_L(0); MMA(1, 0, At, B0); BAR; SCHED;
    STAGE(SB(0, 1), b2 + hstep, voffB);
    WAIT_V(6); BAR; MMA(1, 1, At, B1); BAR;
    LDB(B0, 1, 0); SCHED; LDA(At, 1, 0); STAGE(SA(0, 1), a2 + hstep, voffA);
    WAIT_L(8); BAR; WAIT_L(0); MMA(0, 0, At, B0); BAR; SCHED;
    LDB(B1, 1, 1); STAGE(SB(1, 0), b3, voffB);
    BAR; WAIT_L(0); MMA(0, 1, At, B1); BAR;
    LDA(At, 1, 1); STAGE(SA(1, 0), a3, voffA);
    BAR; WAIT_L(0); MMA(1, 0, At, B0); BAR; SCHED;
    STAGE(SB(1, 1), b3 + hstep, voffB);
    WAIT_V(6); BAR; MMA(1, 1, At, B1); BAR;
  }
  { LDB(B0, 0, 0); LDA(At, 0, 0); STAGE(SA(1, 1), cA + (size_t)(nt - 1) * kstep + hstep, voffA);
    BAR; WAIT_L(0); MMA(0, 0, At, B0); BAR;
    LDB(B1, 0, 1); BAR; WAIT_L(0); MMA(0, 1, At, B1); BAR;
    LDA(At, 0, 1); WAIT_V(4); BAR; WAIT_L(0); MMA(1, 0, At, B0); MMA(1, 1, At, B1); BAR; }
  { LDB(B0, 1, 0); LDA(At, 1, 0); WAIT_V(2); BAR; WAIT_L(0); MMA(0, 0, At, B0); BAR;
    LDB(B1, 1, 1); WAIT_V(0); BAR; WAIT_L(0); MMA(0, 1, At, B1); BAR;
    LDA(At, 1, 1); BAR; WAIT_L(0); MMA(1, 0, At, B0); MMA(1, 1, At, B1); BAR; }
  if (wr == 0) BAR;
  epi(acc, brow + wr * 64 + fr, bcol + wc * 32 + 8 * fq);
#undef SA
#undef SB
#undef STAGE
#undef LDA
#undef LDB
#undef MMA
}

struct EpiProj {
  bf16_t* O; int ldo; int mode; const float* gain; int ghs; float scale; char* smem; bf16_t* ug; int ugc;
  DI void init(f32x4 (&acc)[2][2][4][2], int, int) const {
#pragma unroll
    for (int a = 0; a < 2; ++a)
#pragma unroll
      for (int b = 0; b < 2; ++b)
#pragma unroll
        for (int m = 0; m < 4; ++m) { acc[a][b][m][0] = (f32x4){0.f, 0.f, 0.f, 0.f}; acc[a][b][m][1] = (f32x4){0.f, 0.f, 0.f, 0.f}; }
  }
  DI void operator()(f32x4 (&acc)[2][2][4][2], int row0, int col0) const {
    const int tid = threadIdx.x, wid = tid >> 6, lane = tid & 63, fr = lane & 15, fq = lane >> 4, wc = wid & 3;
    float f[2][2][4];
    f32x4 g[2][2];
#pragma unroll
    for (int ai = 0; ai < 2; ++ai)
#pragma unroll
      for (int m = 0; m < 4; ++m) { f[0][ai][m] = 1.0f; f[1][ai][m] = 1.0f; }
#pragma unroll
    for (int bj = 0; bj < 2; ++bj) { g[bj][0] = (f32x4){1.f, 1.f, 1.f, 1.f}; g[bj][1] = (f32x4){1.f, 1.f, 1.f, 1.f}; }
    if (mode == 2) {
      LDS3 float* red = (LDS3 float*)smem;
      float part[2][2][4];
#pragma unroll
      for (int bj = 0; bj < 2; ++bj)
#pragma unroll
        for (int ai = 0; ai < 2; ++ai)
#pragma unroll
          for (int m = 0; m < 4; ++m) {
            const f32x4 a = acc[ai][bj][m][0], b = acc[ai][bj][m][1];
            float ss = a[0] * a[0] + a[1] * a[1] + a[2] * a[2] + a[3] * a[3] + b[0] * b[0] + b[1] * b[1] + b[2] * b[2] + b[3] * b[3];
            ss += __shfl_xor(ss, 16); ss += __shfl_xor(ss, 32);
            part[bj][ai][m] = ss;
            if (fq == 0) red[((wid * 2 + bj) * 8 + ai * 4 + m) * 16 + fr] = ss;
          }
      __syncthreads();
#pragma unroll
      for (int bj = 0; bj < 2; ++bj) {
        const int head = bj * 2 + (wc >> 1);
        const float* gp = gain + head * ghs + (wc & 1) * 32 + 8 * fq;
        g[bj][0] = *(const f32x4*)gp * scale; g[bj][1] = *(const f32x4*)(gp + 4) * scale;
#pragma unroll
        for (int ai = 0; ai < 2; ++ai)
#pragma unroll
          for (int m = 0; m < 4; ++m) {
            const float tot = part[bj][ai][m] + red[(((wid ^ 1) * 2 + bj) * 8 + ai * 4 + m) * 16 + fr];
            f[bj][ai][m] *= rsqrtf(tot * (1.0f / 64.0f) + 1e-6f);
          }
      }
    }
    if (mode == 3) {
#pragma unroll
      for (int ai = 0; ai < 2; ++ai)
#pragma unroll
        for (int m = 0; m < 4; ++m) {
          const f32x4 u0 = acc[ai][0][m][0], u1 = acc[ai][0][m][1], g0 = acc[ai][1][m][0], g1 = acc[ai][1][m][1];
          u32x4 pq;
          pq[0] = pk_bf16(u0[0] * silu_f(g0[0]), u0[1] * silu_f(g0[1])); pq[1] = pk_bf16(u0[2] * silu_f(g0[2]), u0[3] * silu_f(g0[3]));
          pq[2] = pk_bf16(u1[0] * silu_f(g1[0]), u1[1] * silu_f(g1[1])); pq[3] = pk_bf16(u1[2] * silu_f(g1[2]), u1[3] * silu_f(g1[3]));
          *(u32x4*)(ug + (size_t)(row0 + ai * HALF + m * 16) * 256 + ugc + (col0 & 127)) = pq;
        }
      return;
    }
    const bool silu = mode == 1;
#pragma unroll
    for (int ai = 0; ai < 2; ++ai)
#pragma unroll
      for (int m = 0; m < 4; ++m)
#pragma unroll
        for (int bj = 0; bj < 2; ++bj) {
          f32x4 v0 = acc[ai][bj][m][0], v1 = acc[ai][bj][m][1];
          if (mode == 2) { v0 = v0 * g[bj][0] * f[bj][ai][m]; v1 = v1 * g[bj][1] * f[bj][ai][m]; }
          if (silu) {
#pragma unroll
            for (int j = 0; j < 4; ++j) { v0[j] = silu_f(v0[j]); v1[j] = silu_f(v1[j]); }
          }
          u32x4 pk; pk[0] = pk_bf16(v0[0], v0[1]); pk[1] = pk_bf16(v0[2], v0[3]); pk[2] = pk_bf16(v1[0], v1[1]); pk[3] = pk_bf16(v1[2], v1[3]);
          *(u32x4*)(O + (size_t)(row0 + ai * HALF + m * 16) * ldo + col0 + bj * HALF) = pk;
        }
    if (mode == 2) __syncthreads();
  }
};

struct EpiOut {
  float* out; const float* x;
  DI void init(f32x4 (&acc)[2][2][4][2], int row0, int col0) const {
    const unsigned voff = ((unsigned)row0 * 1024u + (unsigned)col0) * 4u;
#pragma unroll
    for (int ai = 0; ai < 2; ++ai)
#pragma unroll
      for (int m = 0; m < 4; ++m) {
        const char* rb = (const char*)x + (size_t)(ai * HALF + m * 16) * 4096;
#pragma unroll
        for (int bj = 0; bj < 2; ++bj)
#pragma unroll
          for (int n = 0; n < 2; ++n) acc[ai][bj][m][n] = *(const f32x4*)(rb + voff + (bj * HALF + 4 * n) * 4);
      }
  }
  DI void operator()(f32x4 (&acc)[2][2][4][2], int row0, int col0) const {
    unsigned voff = ((unsigned)row0 * 1024u + (unsigned)col0) * 4u;
    asm volatile("" : "+v"(voff));
#pragma unroll
    for (int ai = 0; ai < 2; ++ai)
#pragma unroll
      for (int m = 0; m < 4; ++m) {
        char* rb = (char*)out + (size_t)(ai * HALF + m * 16) * 4096;
#pragma unroll
        for (int bj = 0; bj < 2; ++bj)
#pragma unroll
          for (int n = 0; n < 2; ++n) *(f32x4*)(rb + voff + (bj * HALF + 4 * n) * 4) = acc[ai][bj][m][n];
      }
  }
};

DI void tile_order(int L, int nM, int nN, int& pm, int& pn) {
  const int nwg = nM * nN;
  int wgid = L; { const int q = nwg / 8, r = nwg % 8, xcd = wgid % 8, off = wgid / 8; wgid = (xcd < r ? xcd * (q + 1) : r * (q + 1) + (xcd - r) * q) + off; }
  const int nig = 8 * nN, gid = wgid / nig, fm = gid * 8, gsz = (nM - fm) < 8 ? (nM - fm) : 8;
  pm = fm + ((wgid % nig) % gsz); pn = (wgid % nig) / gsz;
}

constexpr int NTAIL = 72;
DI void phase_gemm1(const Params& p, char* smem, const XcdBarrier& xb) {
  constexpr int NMAIN = 64 * 12;
  const int G = gridDim.x;
  const int nmain = (NMAIN + G - 1) / G;
  for (int k = 0; k <= nmain; ++k) {
    if (k == nmain) xcd_barrier(xb);
    for (int it = (k < nmain ? blockIdx.x + k * G : blockIdx.x); it < (k < nmain ? min(NMAIN, (k + 1) * G) : NTAIL); it += G) {
      bool main_t = true; int pm, pn;
      if (k < nmain) tile_order(it, 64, 12, pm, pn);
      else if (it < 64) { pm = it; pn = 12; }
      else { main_t = false; pm = (it - 64) >> 1; pn = (it - 64) & 1; }
      int mode = 0; const float* gain = p.aq_gain; int ghs = 0; float scale = 1.0f;
      if (main_t) {
        if (pn == 1) { mode = 2; gain = p.gv_gain; ghs = 64; }
        else if (pn == 0 || pn == 2) mode = 3;
        else if (pn == 9 || pn == 10 || pn == 12) mode = 1;
        else if (pn == 3 || pn == 4) { mode = 2; gain = p.aq_gain; scale = QSCALE; }
        else if (pn == 5 || pn == 6) { mode = 2; gain = p.ak_gain; }
        else if (pn == 11) { mode = 2; gain = p.mq_gain; scale = QSCALE; }
      } else if (pn == 0) { mode = 2; gain = p.mk_gain; }
      const EpiProj e{main_t ? p.proj : p.memkv, main_t ? IN_W : 512, mode, gain, ghs, scale, smem, p.ug, pn == 2 ? 128 : 0};
      gemm256<1024>(main_t ? p.xb : p.memb, main_t ? p.wt_in : p.wt_mem, pm * 256, pn * 256, smem, e);
    }
  }
}

DI void phase_gemm2(const Params& p, char* smem) {
  constexpr int NT = 64 * 4;
  const EpiOut e{p.out, p.x};
  for (int it = blockIdx.x; it < NT; it += gridDim.x) { int pm, pn; tile_order(it, 64, 4, pm, pn); gemm256<1024>(p.mix, p.wt_out, pm * 256, pn * 256, smem, e); }
}

DI u32x4 headnorm_chunk(u32x4 v, const float* gain8, float scale) {
  float f[8];
#pragma unroll
  for (int e = 0; e < 4; ++e) { f[2 * e] = bf_lo(v[e]); f[2 * e + 1] = bf_hi(v[e]); }
  float ss = 0.f;
#pragma unroll
  for (int e = 0; e < 8; ++e) ss += f[e] * f[e];
  ss += __shfl_xor(ss, 1); ss += __shfl_xor(ss, 2); ss += __shfl_xor(ss, 4);
  const float hn = rsqrtf(ss * (1.0f / 64.0f) + 1e-6f) * scale;
  const f32x4 g0 = *(const f32x4*)gain8, g1 = *(const f32x4*)(gain8 + 4);
  u32x4 r;
  r[0] = pk_bf16(f[0] * hn * g0[0], f[1] * hn * g0[1]); r[1] = pk_bf16(f[2] * hn * g0[2], f[3] * hn * g0[3]);
  r[2] = pk_bf16(f[4] * hn * g1[0], f[5] * hn * g1[1]); r[3] = pk_bf16(f[6] * hn * g1[2], f[7] * hn * g1[3]);
  return r;
}

constexpr int LDT = 72;
struct AttnDesc {
  const bf16_t* qp; long qs;
  const bf16_t* base; long koff, voff, ks;
  int jmin;
};
template <int NCH> struct AttnRegs { u32x4 kr[NCH], vr[NCH], qr[2][2]; };
template <int NCH> DI void attn_load(const AttnDesc& d, AttnRegs<NCH>& R) {
  const int tid = tid_opaque(), lane = tid & 63, w = tid >> 6, fr = lane & 15, fq = lane >> 4;
#pragma unroll
  for (int i = 0; i < NCH; ++i) {
    const int c = tid + NTHREADS * i, j = c >> 3, ch = (c & 7) * 8;
    if (j >= d.jmin) { R.kr[i] = *(const u32x4*)(d.base + (d.koff + (long)j * d.ks + ch)); R.vr[i] = *(const u32x4*)(d.base + (d.voff + (long)j * d.ks + ch)); }
  }
#pragma unroll
  for (int qt = 0; qt < 2; ++qt)
#pragma unroll
    for (int k2 = 0; k2 < 2; ++k2) R.qr[qt][k2] = *(const u32x4*)(d.qp + (long)(32 * w + 16 * qt + fr) * d.qs + k2 * 32 + fq * 8);
}
template <int NCH> DI void attn_stage(char* smem, int jmin, const AttnRegs<NCH>& R, bf16x8 (&qf)[2][2]) {
  const int tid = tid_opaque();
  bf16_t* Ks = (bf16_t*)smem; bf16_t* Vs = (bf16_t*)(smem + NCH * 64 * LDT * 2);
#pragma unroll
  for (int i = 0; i < NCH; ++i) {
    const int c = tid + NTHREADS * i, j = c >> 3, ch = (c & 7) * 8;
    if (j >= jmin) { *(u32x4*)(Ks + j * LDT + ch) = R.kr[i]; *(u32x4*)(Vs + j * LDT + ch) = R.vr[i]; }
  }
#pragma unroll
  for (int qt = 0; qt < 2; ++qt)
#pragma unroll
    for (int k2 = 0; k2 < 2; ++k2) qf[qt][k2] = __builtin_bit_cast(bf16x8, R.qr[qt][k2]);
}
template <int NCH> DI void attn_compute(char* smem, const bf16x8 (&qf)[2][2], int jmin, bool masked, float bound2, bf16_t* op, long os, float* lp, long ls, const bf16_t* gp, long gs) {
  const int tid = tid_opaque(), lane = tid & 63, w = tid >> 6, fr = lane & 15, fq = lane >> 4;
  LDS3 bf16_t* Ks = (LDS3 bf16_t*)smem; LDS3 bf16_t* Vs = (LDS3 bf16_t*)(smem + NCH * 64 * LDT * 2);
  f32x4 o[2][4], ol[2];
#pragma unroll
  for (int qt = 0; qt < 2; ++qt) {
    ol[qt] = (f32x4){0.f, 0.f, 0.f, 0.f};
#pragma unroll
    for (int dt = 0; dt < 4; ++dt) o[qt][dt] = (f32x4){0.f, 0.f, 0.f, 0.f};
  }
  const int jt_lo = masked ? (w > (jmin >> 5) ? w : (jmin >> 5)) : 0;
  const int jt_hi = masked ? w + 5 : 8;
  const int qq = (lane & 15) >> 2, pp = lane & 3;
  const float nb = -bound2;
  const bf16x8 ones = {0x3F80, 0x3F80, 0x3F80, 0x3F80, 0x3F80, 0x3F80, 0x3F80, 0x3F80};
  for (int jt = jt_lo; jt < jt_hi; ++jt) {
    f32x4 s[2][2];
#pragma unroll
    for (int kt = 0; kt < 2; ++kt) {
      s[0][kt] = (f32x4){nb, nb, nb, nb}; s[1][kt] = (f32x4){nb, nb, nb, nb};
#pragma unroll
      for (int k2 = 0; k2 < 2; ++k2) {
        const bf16x8 kf = *(const LDS3 bf16x8*)(Ks + (32 * jt + 16 * kt + fr) * LDT + k2 * 32 + fq * 8);
        s[0][kt] = mfma16(kf, qf[0][k2], s[0][kt]);
        s[1][kt] = mfma16(kf, qf[1][k2], s[1][kt]);
      }
    }
    bf16x8 pf[2];
    const bool edge = masked && (jt == w || jt == w + 4);
#pragma unroll
    for (int qt = 0; qt < 2; ++qt) {
      float pv[8];
#pragma unroll
      for (int kt = 0; kt < 2; ++kt)
#pragma unroll
        for (int r = 0; r < 4; ++r) pv[kt * 4 + r] = __builtin_amdgcn_exp2f(s[qt][kt][r]);
      if (edge) {
        const int iq = 32 * w + 16 * qt + fr;
#pragma unroll
        for (int kt = 0; kt < 2; ++kt)
#pragma unroll
          for (int r = 0; r < 4; ++r) {
            const int j = 32 * jt + 16 * kt + fq * 4 + r;
            if (!(j >= iq && j <= iq + 128)) pv[kt * 4 + r] = 0.f;
          }
      }
      u32x4 pk; pk[0] = pk_bf16(pv[0], pv[1]); pk[1] = pk_bf16(pv[2], pv[3]); pk[2] = pk_bf16(pv[4], pv[5]); pk[3] = pk_bf16(pv[6], pv[7]);
      pf[qt] = __builtin_bit_cast(bf16x8, pk);
    }
    ol[0] = mfma16(ones, pf[0], ol[0]); ol[1] = mfma16(ones, pf[1], ol[1]);
#pragma unroll
    for (int dt = 0; dt < 4; ++dt) {
      const s16x4 lo = __builtin_amdgcn_ds_read_tr16_b64_v4i16((LDS3 s16x4*)(Vs + (32 * jt + fq * 4 + qq) * LDT + dt * 16 + 4 * pp));
      const s16x4 hi = __builtin_amdgcn_ds_read_tr16_b64_v4i16((LDS3 s16x4*)(Vs + (32 * jt + 16 + fq * 4 + qq) * LDT + dt * 16 + 4 * pp));
      const bf16x8 vf = __builtin_shufflevector(lo, hi, 0, 1, 2, 3, 4, 5, 6, 7);
      o[0][dt] = mfma16(vf, pf[0], o[0][dt]);
      o[1][dt] = mfma16(vf, pf[1], o[1][dt]);
    }
  }
#pragma unroll
  for (int qt = 0; qt < 2; ++qt) {
    const long iq = 32 * w + 16 * qt + fr;
    const float l = ol[qt][0];
    if (lp) {
      if (fq == 0) lp[iq * ls] = l;
#pragma unroll
      for (int dt = 0; dt < 4; ++dt) {
        u32x2 pk; pk[0] = pk_bf16(o[qt][dt][0], o[qt][dt][1]); pk[1] = pk_bf16(o[qt][dt][2], o[qt][dt][3]);
        *(u32x2*)(op + iq * os + dt * 16 + fq * 4) = pk;
      }
    } else {
      const float inv = __builtin_amdgcn_rcpf(l);
#pragma unroll
      for (int dt = 0; dt < 4; ++dt) {
        const u32x2 g = *(const u32x2*)(gp + iq * gs + dt * 16 + fq * 4);
        u32x2 pk;
        pk[0] = pk_bf16(o[qt][dt][0] * inv * bf_lo(g[0]), o[qt][dt][1] * inv * bf_hi(g[0]));
        pk[1] = pk_bf16(o[qt][dt][2] * inv * bf_lo(g[1]), o[qt][dt][3] * inv * bf_hi(g[1]));
        *(u32x2*)(op + iq * os + dt * 16 + fq * 4) = pk;
      }
    }
  }
}

constexpr int LDV = 136;
DI void gmlp_item(const Params& p, char* smem, int b, int c, int h) {
  const int tid = tid_opaque(), lane = tid & 63, w = tid >> 6, fr = lane & 15, fq = lane >> 4;
  const size_t tok0 = (size_t)b * SEQ + c * 128;
  bf16_t* vT = (bf16_t*)smem;
  const int t = 16 * w + fr;
  const bf16_t* wrow = p.wsb + (size_t)h * 16384 + (size_t)t * 128 + fq * 8;
  bf16x8 af[4];
#pragma unroll
  for (int k3 = 0; k3 < 4; ++k3) af[k3] = *(const bf16x8*)(wrow + k3 * 32);
  const float bias = p.gmlp_b[h * 128 + t];
  const bool oddq = fq & 1;
  const int dbase = (oddq ? 16 : 0) + (fq & 2) * 4;
  const bf16_t* ugrow = p.ug + (tok0 + t) * 256 + h * 64 + dbase;
  u32x4 uu[2];
#pragma unroll
  for (int np = 0; np < 2; ++np) uu[np] = *(const u32x4*)(ugrow + np * 32);
#pragma unroll
  for (int i = 0; i < 2; ++i) {
    const int ci = tid + NTHREADS * i, s = ci >> 3, ch = (ci & 7) * 8;
    *(u32x4*)(vT + s * LDT + ch) = *(const u32x4*)(p.proj + (tok0 + s) * IN_W + C_GV + h * 64 + ch);
  }
  __syncthreads();
  f32x4 acc[4];
#pragma unroll
  for (int n = 0; n < 4; ++n) acc[n] = (f32x4){0.f, 0.f, 0.f, 0.f};
  LDS3 bf16_t* vS = (LDS3 bf16_t*)smem;
  const int qq = (lane & 15) >> 2, pp = lane & 3;
#pragma unroll
  for (int k3 = 0; k3 < 4; ++k3) {
    if (k3 <= (w >> 1)) {
#pragma unroll
      for (int n = 0; n < 4; ++n) {
        const s16x4 blo = __builtin_amdgcn_ds_read_tr16_b64_v4i16((LDS3 s16x4*)(vS + (k3 * 32 + fq * 8 + qq) * LDT + n * 16 + 4 * pp));
        const s16x4 bhi = __builtin_amdgcn_ds_read_tr16_b64_v4i16((LDS3 s16x4*)(vS + (k3 * 32 + fq * 8 + 4 + qq) * LDT + n * 16 + 4 * pp));
        const bf16x8 bfr = __builtin_shufflevector(blo, bhi, 0, 1, 2, 3, 4, 5, 6, 7);
        acc[n] = mfma16(bfr, af[k3], acc[n]);
      }
    }
  }
  {
    bf16_t* orow = p.mix + (tok0 + t) * 1024 + h * 64 + dbase;
#pragma unroll
    for (int np = 0; np < 2; ++np) {
      const f32x4 own = oddq ? acc[2 * np + 1] : acc[2 * np];
      const f32x4 snd = oddq ? acc[2 * np] : acc[2 * np + 1];
      f32x4 rcv;
#pragma unroll
      for (int r = 0; r < 4; ++r) rcv[r] = __shfl_xor(snd[r], 16);
      const f32x4 lo = oddq ? rcv : own, hi = oddq ? own : rcv;
      const u32x4 u = uu[np];
      u32x4 pk;
      pk[0] = pk_bf16(bf_lo(u[0]) * (lo[0] + bias), bf_hi(u[0]) * (lo[1] + bias)); pk[1] = pk_bf16(bf_lo(u[1]) * (lo[2] + bias), bf_hi(u[1]) * (lo[3] + bias));
      pk[2] = pk_bf16(bf_lo(u[2]) * (hi[0] + bias), bf_hi(u[2]) * (hi[1] + bias)); pk[3] = pk_bf16(bf_lo(u[3]) * (hi[2] + bias), bf_hi(u[3]) * (hi[3] + bias));
      *(u32x4*)(orow + np * 32) = pk;
    }
  }
  __syncthreads();
}

struct DilItem { AttnDesc d; long tokq0; int dil, cfg, h; };
DI DilItem dil_item(const Params& p, int it) {
  DilItem I;
  const int idx = it & 15, cfg = (it >> 4) % 3, bh = it / 48, h = bh & 7, b = bh >> 3;
  const int sh = cfg * 2, dil = 1 << sh;
  const int r = idx & (dil - 1), nb2 = idx >> sh;
  const long tokq0 = (long)b * SEQ + (long)(256 * nb2) * dil + r;
  const long tokk0 = tokq0 - 128L * dil;
  I.d.qp = p.proj + tokq0 * IN_W + C_AQ + h * 64; I.d.qs = (long)dil * IN_W;
  I.d.base = p.proj; I.d.koff = tokk0 * IN_W + C_AK + h * 64; I.d.voff = tokk0 * IN_W + C_AV + h * 64; I.d.ks = (long)dil * IN_W;
  I.d.jmin = nb2 == 0 ? 128 : 0;
  I.tokq0 = tokq0; I.dil = dil; I.cfg = cfg; I.h = h;
  return I;
}

constexpr int TAIL_COST_ITEMS = 5;
DI void phase_mix(const Params& p, char* smem, volatile LDS3 unsigned* st) {
  constexpr int N_DIL = BATCH * 8 * 3 * 16, N_G = BATCH * 32 * 4;
  const float bound_a = p.bounds[0];
  const int G = gridDim.x;
  {
    int first, step, end; bool xmap = false;
    int x = 0;
    if (G == 256) {
      xmap = true; x = blockIdx.x & 7;
      const int j = blockIdx.x >> 3;
      constexpr int PER_X = N_DIL / 8, NB = NTAIL / 8, NAB = 32 - NB;
      constexpr int NA = ((PER_X + NB * TAIL_COST_ITEMS) * NAB + 16) / 32 < PER_X ? ((PER_X + NB * TAIL_COST_ITEMS) * NAB + 16) / 32 : PER_X;
      if (j >= NB) { first = j - NB; step = NAB; end = NA; } else { first = NA + j; step = NB; end = PER_X; }
    } else { first = blockIdx.x; step = G; end = N_DIL; }
    auto item_of = [&](int v) { return xmap ? (x + 8 * (v / 48)) * 48 + (v % 48) : v; };
    AttnRegs<6> R;
    int it = first;
    DilItem cur = dil_item(p, item_of(it < end ? it : 0));
    if (it < end) attn_load<6>(cur.d, R);
    for (; it < end; it += step) {
      bf16x8 qf[2][2];
      attn_stage<6>(smem, cur.d.jmin, R, qf);
      __syncthreads();
      const DilItem me = cur;
      if (it + step < end) { cur = dil_item(p, item_of(it + step)); attn_load<6>(cur.d, R); }
      attn_compute<6>(smem, qf, me.d.jmin, true, bound_a,
                   p.opart + ((size_t)me.cfg * NTOK + me.tokq0) * 512 + me.h * 64, (long)me.dil * 512, p.lpart + ((size_t)me.cfg * NTOK + me.tokq0) * 8 + me.h, (long)me.dil * 8, nullptr, 0);
      __syncthreads();
    }
  }
  {
    unsigned* ctr = p.bar + XCD_BAR_WORDS;
    const int tid = threadIdx.x;
    if (tid == 0) st[2] = atomicAdd(ctr, 1u);
    __syncthreads();
    int t = __builtin_amdgcn_readfirstlane((int)st[2]);
    while (t < N_G) {
      unsigned nx = 0u;
      if (tid == 0) nx = atomicAdd(ctr, 1u);
      const int h = t & 3, c = (t >> 2) & 31, b = t >> 7;
      gmlp_item(p, smem, b, c, h);
      if (tid == 0) st[2] = nx;
      __syncthreads();
      t = __builtin_amdgcn_readfirstlane((int)st[2]);
    }
  }
}

DI void phase_mem(const Params& p, char* smem) {
  constexpr int N_PAIR = BATCH * 4 * 16;
  const float bound_m = p.bounds[1];
  for (int pr = blockIdx.x; pr < N_PAIR; pr += gridDim.x) {
    const int tile = (pr & 15) * 2, mh = (pr >> 4) & 3, b = pr >> 6;
    const long tok0 = (long)b * SEQ + tile * 128;
    AttnDesc d; d.qp = p.proj + tok0 * IN_W + C_MQ + mh * 64; d.qs = IN_W; d.base = p.memkv; d.koff = (long)b * MEM_LEN * 512 + mh * 64; d.voff = d.koff + 256; d.ks = 512; d.jmin = 0;
    AttnRegs<4> R; bf16x8 qf[2][2];
    attn_load<4>(d, R);
    attn_stage<4>(smem, 0, R, qf);
    __syncthreads();
    attn_compute<4>(smem, qf, 0, false, bound_m, p.mix + tok0 * 1024 + 768 + mh * 64, 1024, nullptr, 0, p.proj + tok0 * IN_W + C_MG + mh * 64, IN_W);
    __syncthreads();
  }
}

DI void phase_combine(const Params& p) {
  constexpr int NCH = NTOK * 64;
  for (int ci = blockIdx.x * NTHREADS + tid_opaque(); ci < NCH; ci += gridDim.x * NTHREADS) {
    const int tok = ci >> 6, col = (ci & 63) * 8, h = col >> 6;
    float l = 0.f; float o[8] = {0.f, 0.f, 0.f, 0.f, 0.f, 0.f, 0.f, 0.f};
#pragma unroll
    for (int cfg = 0; cfg < 3; ++cfg) {
      l += p.lpart[((size_t)cfg * NTOK + tok) * 8 + h];
      const u32x4 v = *(const u32x4*)(p.opart + ((size_t)cfg * NTOK + tok) * 512 + col);
#pragma unroll
      for (int e = 0; e < 4; ++e) { o[2 * e] += bf_lo(v[e]); o[2 * e + 1] += bf_hi(v[e]); }
    }
    const u32x4 g = *(const u32x4*)(p.proj + (size_t)tok * IN_W + C_AG + col);
    const float inv = __builtin_amdgcn_rcpf(l);
    u32x4 pk;
#pragma unroll
    for (int e = 0; e < 4; ++e) pk[e] = pk_bf16(o[2 * e] * inv * bf_lo(g[e]), o[2 * e + 1] * inv * bf_hi(g[e]));
    *(u32x4*)(p.mix + (size_t)tok * 1024 + 256 + col) = pk;
  }
}


__global__ void __launch_bounds__(NTHREADS, 2) fwd_kernel(Params p, int use_cg) {
  extern __shared__ __attribute__((aligned(16))) char smem[];
  __shared__ uint4 xb_words;
  if (threadIdx.x == 0) xb_words = make_uint4(0u, 0u, 0u, 0u);
  __syncthreads();
  XcdBarrier xb = xcd_barrier_post(p.bar, (volatile LDS3 unsigned*)&xb_words);
  phase_prep(p, smem);
  xcd_barrier(xb);
  phase_gemm1(p, smem, xb);
  phase_mix(p, smem, (volatile LDS3 unsigned*)&xb_words);
  xcd_barrier(xb);
  phase_mem(p, smem);
  phase_combine(p);
  xcd_barrier(xb);
  phase_gemm2(p, smem);
}

extern "C" void kernel_launch(void* const* d_in, const int* in_sizes, int n_in, void* d_out, int out_size, void* d_ws, size_t ws_size, hipStream_t stream) {
  static int grid_blocks = 0;
  if (!grid_blocks) {
    int dev = 0, cus = 0, per_cu = 0;
    hipGetDevice(&dev);
    hipDeviceGetAttribute(&cus, hipDeviceAttributeMultiprocessorCount, dev);
    hipFuncSetAttribute((const void*)fwd_kernel, hipFuncAttributeMaxDynamicSharedMemorySize, SMEM_BYTES);
    hipOccupancyMaxActiveBlocksPerMultiprocessor(&per_cu, fwd_kernel, NTHREADS, SMEM_BYTES);
    if (per_cu != 1) per_cu = 1;
    grid_blocks = cus * per_cu;
  }
  Params p{};
  p.x = (const float*)d_in[0]; p.mem = (const float*)d_in[1]; p.norm_gain = (const float*)d_in[2]; p.w_in = (const float*)d_in[3];
  p.gv_gain = (const float*)d_in[4]; p.w_s = (const float*)d_in[5]; p.gmlp_b = (const float*)d_in[6]; p.aq_gain = (const float*)d_in[7];
  p.ak_gain = (const float*)d_in[8]; p.mem_norm_gain = (const float*)d_in[9]; p.w_mem_kv = (const float*)d_in[10]; p.mq_gain = (const float*)d_in[11];
  p.mk_gain = (const float*)d_in[12]; p.w_out = (const float*)d_in[13];
  p.out = (float*)d_out;
  char* ws = (char*)d_ws; size_t off = 0;
  auto take = [&](size_t bytes) { char* r = ws + off; off += (bytes + 255) & ~(size_t)255; return r; };
  p.wt_in = (bf16_t*)take((size_t)IN_W * 1024 * 2);
  p.wt_out = (bf16_t*)take((size_t)1024 * 1024 * 2);
  p.wt_mem = (bf16_t*)take((size_t)512 * 1024 * 2);
  p.wsb = (bf16_t*)take((size_t)4 * 128 * 128 * 2);
  p.xb = (bf16_t*)take((size_t)NTOK * 1024 * 2);
  p.memb = (bf16_t*)take((size_t)NMEM * 1024 * 2);
  p.proj = (bf16_t*)take((size_t)NTOK * IN_W * 2);
  p.memkv = (bf16_t*)take((size_t)NMEM * 512 * 2);
  p.opart = (bf16_t*)take((size_t)3 * NTOK * 512 * 2);
  p.mix = (bf16_t*)take((size_t)NTOK * 1024 * 2);
  p.ug = (bf16_t*)take((size_t)NTOK * 256 * 2);
  p.lpart = (float*)take((size_t)3 * NTOK * 8 * 4);
  p.bounds = (float*)take(256);
  p.bar = (unsigned*)take((size_t)(XCD_BAR_WORDS + 64) * 4);
  if (off > ws_size) { fprintf(stderr, "workspace too small: need %zu have %zu\n", off, ws_size); return; }
  hipMemsetAsync(p.bar, 0, (size_t)(XCD_BAR_WORDS + 64) * 4, stream);
  int use_cg = 0;
  void* args[] = {&p, &use_cg};
  hipError_t e = hipLaunchCooperativeKernel((void*)fwd_kernel, dim3(grid_blocks), dim3(NTHREADS), args, SMEM_BYTES, stream);
  if (e != hipSuccess) fprintf(stderr, "cooperative launch failed: %s (grid %d)\n", hipGetErrorString(e), grid_blocks);
}
```
